# Optimizing an MI355X kernel written in HIP

```python
import jax, jax.numpy as jnp
from jax import lax
import numpy as np

D_MODEL = 1024
BATCH = 2
SEQ = 8192
DEPTH = 1

N_HEADS = 8
HEAD_DIM = 64
ATTN_WIDTH = N_HEADS * HEAD_DIM
IDX_HEADS = 8
IDX_DIM = 64
TOPK_MAX = 256
Q_BLOCK = 128
CONV_CH = 512
CONV_WIDTH = 31
D_FF = -(-8 * D_MODEL // (3 * 256)) * 256
N_MOD = 6
EPS = 1e-6

kernel_name = "hybrid_dsa_conformer_gated_block"


def _in_split_sizes():
    return [ATTN_WIDTH, ATTN_WIDTH, ATTN_WIDTH,
            IDX_HEADS * IDX_DIM, IDX_DIM, IDX_HEADS,
            2 * CONV_CH, D_MODEL, D_MODEL]


def rmsnorm(x, g):
    xf = x.astype(jnp.float32)
    y = xf * lax.rsqrt(jnp.mean(xf * xf, axis=-1, keepdims=True) + EPS) * g.astype(jnp.float32)
    return y.astype(x.dtype)


def layernorm(x, g, b):
    xf = x.astype(jnp.float32)
    mu = jnp.mean(xf, axis=-1, keepdims=True)
    var = jnp.mean(jnp.square(xf - mu), axis=-1, keepdims=True)
    y = (xf - mu) * lax.rsqrt(var + EPS) * g.astype(jnp.float32) + b.astype(jnp.float32)
    return y.astype(x.dtype)


def modulate(h, shift, scale):
    return h * (1.0 + scale[:, None, :]) + shift[:, None, :]


def dsa_attention(q, k, v, q_idx, k_idx, w_idx):
    B, S = q.shape[0], q.shape[1]
    topk = min(TOPK_MAX, S // 4)
    n_blocks = S // Q_BLOCK
    f32 = jnp.float32
    slopes = jnp.exp2(-8.0 * jnp.arange(1, N_HEADS + 1, dtype=f32) / N_HEADS)
    key_pos = jnp.arange(S)
    k_idx32 = k_idx.astype(f32)
    gather = jax.vmap(lambda arr, ix: arr[ix])

    def one_block(i):
        start = i * Q_BLOCK
        qb = lax.dynamic_slice_in_dim(q, start, Q_BLOCK, axis=1).astype(f32)
        qib = lax.dynamic_slice_in_dim(q_idx, start, Q_BLOCK, axis=1).astype(f32)
        wb = lax.dynamic_slice_in_dim(w_idx, start, Q_BLOCK, axis=1).astype(f32)
        q_pos = start + jnp.arange(Q_BLOCK)
        idx_logits = jnp.einsum('btjd,bsd->btjs', qib, k_idx32) * (IDX_DIM ** -0.5)
        score = jnp.einsum('btj,btjs->bts', wb, jax.nn.relu(idx_logits))
        causal = key_pos[None, :] <= q_pos[:, None]
        score = jnp.where(causal[None], score, -jnp.inf)
        _, sel = lax.top_k(score, topk)
        k_sel = gather(k, sel).astype(f32)
        v_sel = gather(v, sel).astype(f32)
        s = jnp.einsum('bthd,btkhd->bhtk', qb, k_sel) * (HEAD_DIM ** -0.5)
        dist = (q_pos[None, :, None] - sel).astype(f32)
        s = s - slopes[None, :, None, None] * dist[:, None]
        valid = sel <= q_pos[None, :, None]
        s = jnp.where(valid[:, None], s, -jnp.inf)
        p = jax.nn.softmax(s, axis=-1)
        out = jnp.einsum('bhtk,btkhd->bthd', p, v_sel)
        return out.astype(q.dtype)

    outs = lax.map(one_block, jnp.arange(n_blocks))
    return jnp.transpose(outs, (1, 0, 2, 3, 4)).reshape(B, S, N_HEADS * HEAD_DIM)


def conformer_conv(u, w_dw, b_dw, ln_g, ln_b):
    a, g = jnp.split(u, 2, axis=-1)
    z = a * jax.nn.sigmoid(g)
    z = lax.conv_general_dilated(z, w_dw, window_strides=(1,), padding=[(CONV_WIDTH - 1, 0)],
                                 dimension_numbers=('NWC', 'WIO', 'NWC'),
                                 feature_group_count=CONV_CH) + b_dw
    z = layernorm(z, ln_g, ln_b)
    return jax.nn.silu(z)


def setup_inputs(seed: int = 0) -> dict:
    key = jax.random.key(seed)
    ks = jax.random.split(key, 20)
    n_in = sum(_in_split_sizes())

    def nrm(k, shape, fan_in, gain=1.0):
        return jax.random.normal(k, shape, jnp.float32) * (gain * fan_in ** -0.5)

    def gain_vec(k, shape):
        return 1.0 + 0.02 * jax.random.normal(k, shape, jnp.float32)

    def small(k, shape):
        return 0.02 * jax.random.normal(k, shape, jnp.float32)

    return {
        "x": jax.random.normal(ks[0], (BATCH, SEQ, D_MODEL), jnp.float32),
        "c": jax.random.normal(ks[1], (BATCH, D_MODEL), jnp.float32),
        "norm_mix_g": gain_vec(ks[2], (DEPTH, D_MODEL)),
        "w_in": nrm(ks[3], (DEPTH, D_MODEL, n_in), D_MODEL),
        "w_dw": nrm(ks[4], (DEPTH, CONV_WIDTH, 1, CONV_CH), CONV_WIDTH),
        "b_dw": small(ks[5], (DEPTH, CONV_CH)),
        "conv_ln_g": gain_vec(ks[6], (DEPTH, CONV_CH)),
        "conv_ln_b": small(ks[7], (DEPTH, CONV_CH)),
        "w_attn_proj": nrm(ks[8], (DEPTH, ATTN_WIDTH, D_MODEL), ATTN_WIDTH),
        "w_conv_proj": nrm(ks[9], (DEPTH, CONV_CH, D_MODEL), CONV_CH),
        "w_out": nrm(ks[10], (DEPTH, D_MODEL, D_MODEL), D_MODEL),
        "norm_ffn_g": gain_vec(ks[11], (DEPTH, D_MODEL)),
        "w_ffn_in": nrm(ks[12], (DEPTH, D_MODEL, 2 * D_FF), D_MODEL),
        "w_ffn_out": nrm(ks[13], (DEPTH, D_FF, D_MODEL), D_FF),
        "w_ada": nrm(ks[14], (DEPTH, D_MODEL, N_MOD * D_MODEL), D_MODEL, 0.5),
        "b_ada": small(ks[15], (DEPTH, N_MOD * D_MODEL)),
        "norm_final_g": gain_vec(ks[16], (D_MODEL,)),
    }


def reference(x, c, norm_mix_g, w_in, w_dw, b_dw, conv_ln_g, conv_ln_b, w_attn_proj,
              w_conv_proj, w_out, norm_ffn_g, w_ffn_in, w_ffn_out, w_ada, b_ada, norm_final_g):
    B, S, _ = x.shape
    split_at = list(np.cumsum(_in_split_sizes())[:-1])
    c_act = jax.nn.silu(c)
    for l in range(DEPTH):
        mod = c_act @ w_ada[l] + b_ada[l]
        sh_m, sc_m, g_m, sh_f, sc_f, g_f = jnp.split(mod, N_MOD, axis=-1)

        h = modulate(rmsnorm(x, norm_mix_g[l]), sh_m, sc_m)
        proj = h @ w_in[l]
        q, k, v, qi, ki, wi, u, ga, gb = jnp.split(proj, split_at, axis=-1)
        q = q.reshape(B, S, N_HEADS, HEAD_DIM)
        k = k.reshape(B, S, N_HEADS, HEAD_DIM)
        v = v.reshape(B, S, N_HEADS, HEAD_DIM)
        qi = qi.reshape(B, S, IDX_HEADS, IDX_DIM)
        wi = wi * (IDX_HEADS ** -0.5)
        y_attn = dsa_attention(q, k, v, qi, ki, wi) @ w_attn_proj[l]
        y_conv = conformer_conv(u, w_dw[l], b_dw[l], conv_ln_g[l], conv_ln_b[l]) @ w_conv_proj[l]
        merged = jax.nn.sigmoid(ga) * y_attn + jax.nn.sigmoid(gb) * y_conv
        x = x + g_m[:, None, :] * (merged @ w_out[l])

        h = modulate(rmsnorm(x, norm_ffn_g[l]), sh_f, sc_f)
        a, b = jnp.split(h @ w_ffn_in[l], 2, axis=-1)
        x = x + g_f[:, None, :] * ((jax.nn.silu(a) * b) @ w_ffn_out[l])
    return rmsnorm(x, norm_final_g)
```

```cpp
#define IDX_SHFL 1
#include <hip/hip_runtime.h>
#include <cstdio>
#include <cstdint>

namespace pg8 {
#define PG8_LAS __attribute__((address_space(3)))
typedef unsigned short bf16_t;
typedef short bf16x8 __attribute__((ext_vector_type(8)));
typedef float f32x4 __attribute__((ext_vector_type(4)));
typedef unsigned u32x4 __attribute__((ext_vector_type(4)));
constexpr int BM = 256, BK = 64, HALF = 128, HTB = HALF * BK * 2  , STAGE_BYTES = 8 * HTB, NXCD = 8, WGM = 8;

__host__ __device__ __forceinline__ int lds_byte(int r, int c) { const int st = (r >> 4) * 2 + (c >> 5), rr = r & 15, cc = c & 31, ob = rr * 64 + cc * 2; return st * 1024 + (ob ^ (((ob >> 9) & 1) << 5)); }
__host__ __device__ __forceinline__ void stage_rc(int b, int& R, int& C) { const int st = b / 1024, sb = b % 1024, swz = sb ^ (((sb >> 9) & 1) << 5); R = (st >> 1) * 16 + swz / 64; C = (st & 1) * 32 + (swz % 64) / 2; }
__host__ __device__ __forceinline__ int perm32(int rho) { const int n = rho >> 4, i = rho & 15; return 8 * (i >> 2) + 4 * n + (i & 3); }

struct Unit { int pm, pn; };
struct Gemm { const bf16_t* A; const bf16_t* Bt; int M, N, K; };

struct StaticOrder {
    int nM, nN, nwg, G, c;
    __host__ __device__ void init(int M, int N, int G_, int c_) { nM = M / BM; nN = N / BM; nwg = nM * nN; G = G_; c = c_; }
    __host__ __device__ bool next(int i, Unit& u) const {
        const long L = (long)i * G + c; if (L >= nwg) return false;
        int wgid = (int)L; { const int q = nwg / NXCD, r = nwg % NXCD, xcd = wgid % NXCD, off = wgid / NXCD; wgid = (xcd < r ? xcd * (q + 1) : r * (q + 1) + (xcd - r) * q) + off; }
        const int nig = WGM * nN, gid = wgid / nig, fm = gid * WGM, gsz = (nM - fm) < WGM ? (nM - fm) : WGM;
        u.pm = fm + ((wgid % nig) % gsz); u.pn = (wgid % nig) / gsz; return true;
    }
    __device__ __forceinline__ void a_ready(const Unit&) const {}
    __device__ __forceinline__ void done(const Unit&) const {}
};

typedef float f32x2_cv __attribute__((ext_vector_type(2))); typedef __bf16 bf16x2_cv __attribute__((ext_vector_type(2)));
__device__ __forceinline__ unsigned cvt_pk_bf16(float lo, float hi) { const f32x2_cv v = {lo, hi}; const bf16x2_cv b = __builtin_convertvector(v, bf16x2_cv); return __builtin_bit_cast(unsigned, b); }
__device__ __forceinline__ float sigm(float x) { return __builtin_amdgcn_rcpf(1.0f + __builtin_amdgcn_exp2f(-1.4426950408889634f * x)); }
__device__ __forceinline__ float bf_lo(unsigned w) { return __builtin_bit_cast(float, w << 16); }
__device__ __forceinline__ float bf_hi(unsigned w) { return __builtin_bit_cast(float, w & 0xffff0000u); }
__device__ __forceinline__ u32x4 pack8(f32x4 v0, f32x4 v1) { u32x4 w; w.x = cvt_pk_bf16(v0[0], v0[1]); w.y = cvt_pk_bf16(v0[2], v0[3]); w.z = cvt_pk_bf16(v1[0], v1[1]); w.w = cvt_pk_bf16(v1[2], v1[3]); return w; }
constexpr float QSCALE = 0.125f * 1.4426950408889634f;

struct EpiInProj {
    static constexpr bool PERM = true, AFTER_DRAIN = false;
    bf16_t *Q, *K, *V, *QI, *Z, *SGA, *SGB, *KI; float* WI;
    __device__ __forceinline__ void operator()(const f32x4 (&acc)[2][2][4][2], const Unit& u, int wr, int wc, int fr, int fq) const {
        const int pn = u.pn; const int row0 = u.pm * BM + wr * 64 + fr;
        if (pn < 8) {
            bf16_t* base = (pn < 2) ? Q : (pn < 4) ? K : (pn < 6) ? V : QI; const float sc = (pn < 2) ? QSCALE : 1.0f;
            const int col0 = (pn & 1) * 256 + wc * 32 + 8 * fq;
#pragma unroll
            for (int ai = 0; ai < 2; ++ai)
#pragma unroll
                for (int m = 0; m < 4; ++m) { bf16_t* rowp = base + (size_t)(row0 + ai * HALF + m * 16) * 512 + col0;
#pragma unroll
                    for (int bj = 0; bj < 2; ++bj) *(u32x4*)(rowp + bj * HALF) = pack8(acc[ai][bj][m][0] * sc, acc[ai][bj][m][1] * sc); }
        } else if (pn < 12) {
            const int col0 = (pn - 8) * 128 + wc * 32 + 8 * fq;
#pragma unroll
            for (int ai = 0; ai < 2; ++ai)
#pragma unroll
                for (int m = 0; m < 4; ++m) { f32x4 z0, z1;
#pragma unroll
                    for (int e = 0; e < 4; ++e) { z0[e] = acc[ai][0][m][0][e] * sigm(acc[ai][1][m][0][e]); z1[e] = acc[ai][0][m][1][e] * sigm(acc[ai][1][m][1][e]); }
                    *(u32x4*)(Z + (size_t)(row0 + ai * HALF + m * 16) * 512 + col0) = pack8(z0, z1); }
        } else if (pn < 20) {
            bf16_t* base = (pn < 16) ? SGA : SGB; const int col0 = ((pn - 12) & 3) * 256 + wc * 32 + 8 * fq;
#pragma unroll
            for (int ai = 0; ai < 2; ++ai)
#pragma unroll
                for (int m = 0; m < 4; ++m) { bf16_t* rowp = base + (size_t)(row0 + ai * HALF + m * 16) * 1024 + col0;
#pragma unroll
                    for (int bj = 0; bj < 2; ++bj) { f32x4 s0, s1;
#pragma unroll
                        for (int e = 0; e < 4; ++e) { s0[e] = sigm(acc[ai][bj][m][0][e]); s1[e] = sigm(acc[ai][bj][m][1][e]); }
                        *(u32x4*)(rowp + bj * HALF) = pack8(s0, s1); } }
        } else {
            if (wc < 2) {
#pragma unroll
                for (int ai = 0; ai < 2; ++ai)
#pragma unroll
                    for (int m = 0; m < 4; ++m) *(u32x4*)(KI + (size_t)(row0 + ai * HALF + m * 16) * 64 + wc * 32 + 8 * fq) = pack8(acc[ai][0][m][0], acc[ai][0][m][1]);
            } else if (wc == 2 && fq == 0) {
#pragma unroll
                for (int ai = 0; ai < 2; ++ai)
#pragma unroll
                    for (int m = 0; m < 4; ++m) { float* p = WI + (size_t)(row0 + ai * HALF + m * 16) * 8; *(f32x4*)p = acc[ai][0][m][0]; *(f32x4*)(p + 4) = acc[ai][0][m][1]; }
            }
        }
    }
};
template <int MODE> struct EpiGate {
    static constexpr bool PERM = true, AFTER_DRAIN = false;
    const bf16_t* G; bf16_t* T; const bf16_t* Tin;
    __device__ __forceinline__ void operator()(const f32x4 (&acc)[2][2][4][2], const Unit& u, int wr, int wc, int fr, int fq) const {
        const int row0 = u.pm * BM + wr * 64 + fr, col0 = u.pn * BM + wc * 32 + 8 * fq;
#pragma unroll
        for (int ai = 0; ai < 2; ++ai)
#pragma unroll
            for (int m = 0; m < 4; ++m) { const size_t off = (size_t)(row0 + ai * HALF + m * 16) * 1024 + col0;
#pragma unroll
                for (int bj = 0; bj < 2; ++bj) { const u32x4 g = *(const u32x4*)(G + off + bj * HALF);
                    f32x4 v0 = acc[ai][bj][m][0], v1 = acc[ai][bj][m][1];
                    v0[0] *= bf_lo(g.x); v0[1] *= bf_hi(g.x); v0[2] *= bf_lo(g.y); v0[3] *= bf_hi(g.y); v1[0] *= bf_lo(g.z); v1[1] *= bf_hi(g.z); v1[2] *= bf_lo(g.w); v1[3] *= bf_hi(g.w);
                    if (MODE == 1) { const u32x4 t = *(const u32x4*)(Tin + off + bj * HALF);
                        v0[0] += bf_lo(t.x); v0[1] += bf_hi(t.x); v0[2] += bf_lo(t.y); v0[3] += bf_hi(t.y); v1[0] += bf_lo(t.z); v1[1] += bf_hi(t.z); v1[2] += bf_lo(t.w); v1[3] += bf_hi(t.w); }
                    *(u32x4*)(T + off + bj * HALF) = pack8(v0, v1); } }
    }
};
struct EpiResid {
    static constexpr bool PERM = false, AFTER_DRAIN = false;
    const float* base; float* out; const float* gate; int gstride;
    __device__ __forceinline__ void operator()(const f32x4 (&acc)[2][2][4][2], const Unit& u, int wr, int wc, int fr, int fq) const {
        const int row0 = u.pm * BM + wr * 64 + fr, col0 = u.pn * BM + wc * 32 + 4 * fq;
        const float* gp = gate + ((u.pm * BM) >= 8192 ? gstride : 0) + col0;
        f32x4 gv[2][2];
#pragma unroll
        for (int bj = 0; bj < 2; ++bj)
#pragma unroll
            for (int n = 0; n < 2; ++n) gv[bj][n] = *(const f32x4*)(gp + bj * HALF + n * 16);
#pragma unroll
        for (int ai = 0; ai < 2; ++ai)
#pragma unroll
            for (int m = 0; m < 4; ++m) { const size_t off = (size_t)(row0 + ai * HALF + m * 16) * 1024 + col0;
#pragma unroll
                for (int bj = 0; bj < 2; ++bj)
#pragma unroll
                    for (int n = 0; n < 2; ++n) { const f32x4 bs = *(const f32x4*)(base + off + bj * HALF + n * 16); *(f32x4*)(out + off + bj * HALF + n * 16) = bs + gv[bj][n] * acc[ai][bj][m][n]; } }
    }
};
struct EpiSwiGLU {
    static constexpr bool PERM = true, AFTER_DRAIN = false;
    bf16_t* H; int ldh;
    __device__ __forceinline__ void operator()(const f32x4 (&acc)[2][2][4][2], const Unit& u, int wr, int wc, int fr, int fq) const {
        const int row0 = u.pm * BM + wr * 64 + fr, col0 = u.pn * 128 + wc * 32 + 8 * fq;
#pragma unroll
        for (int ai = 0; ai < 2; ++ai)
#pragma unroll
            for (int m = 0; m < 4; ++m) { f32x4 h0, h1;
#pragma unroll
                for (int e = 0; e < 4; ++e) { const float a0 = acc[ai][0][m][0][e], a1 = acc[ai][0][m][1][e]; h0[e] = a0 * sigm(a0) * acc[ai][1][m][0][e]; h1[e] = a1 * sigm(a1) * acc[ai][1][m][1][e]; }
                *(u32x4*)(H + (size_t)(row0 + ai * HALF + m * 16) * ldh + col0) = pack8(h0, h1); }
    }
};

template <class Epi, class Sched, bool ALIGN_EPI = false, bool SP2 = false>
__device__ __forceinline__ void gemm_phase(PG8_LAS unsigned char* lds, const Gemm g, const Sched& S, const Epi& E) {
    const int tid = threadIdx.x, wid = __builtin_amdgcn_readfirstlane(tid >> 6), lane = tid & 63, wr = wid >> 2, wc = wid & 3, fr = lane & 15, fq = lane >> 4;
    const int K = g.K, nt = K / BK;
    unsigned voffA[2], voffB[2];
#pragma unroll
    for (int i = 0; i < 2; ++i) { int R, C; stage_rc(tid * 16 + i * 8192, R, C); const int Rb = Epi::PERM ? ((R & ~31) + perm32(R & 31)) : R;
        voffA[i] = (unsigned)(R * K + C) * 2u; voffB[i] = (unsigned)(Rb * K + C) * 2u; }
    const size_t kstep = (size_t)(BK * 2);
    const size_t hstep = (size_t)HALF * K * 2;
    const size_t tstep = 2 * hstep;
    const unsigned ldsw = (unsigned)wid * 1024u;
    const int aoff = lds_byte(wr * 64 + fr, fq * 8), boff = lds_byte(wc * 32 + fr, fq * 8);
#define PG8_SA(b, h) (((b) * 2 + (h)) * HTB)
#define PG8_SB(b, h) ((4 + (b) * 2 + (h)) * HTB)
#define PG8_STAGE(bufoff, gbase, voff) do { _Pragma("unroll") for (int _i = 0; _i < 2; ++_i) \
        __builtin_amdgcn_global_load_lds((const unsigned*)((const char*)(gbase) + (voff)[_i]), (PG8_LAS unsigned*)(lds + (bufoff) + ldsw + _i * 8192), 16, 0, 0); } while (0)
#define PG8_LDA(dst, b, h) do { _Pragma("unroll") for (int m = 0; m < 4; ++m) _Pragma("unroll") for (int k = 0; k < 2; ++k) dst[m][k] = *(const PG8_LAS bf16x8*)(lds + PG8_SA(b, h) + aoff + m * 2048 + k * 1024); } while (0)
#define PG8_LDB(dst, b, h) do { _Pragma("unroll") for (int n = 0; n < 2; ++n) _Pragma("unroll") for (int k = 0; k < 2; ++k) dst[n][k] = *(const PG8_LAS bf16x8*)(lds + PG8_SB(b, h) + boff + n * 2048 + k * 1024); } while (0)
#define PG8_MMA(ai, bj, At, Bt) do { __builtin_amdgcn_s_setprio(1); _Pragma("unroll") for (int m = 0; m < 4; ++m) _Pragma("unroll") for (int n = 0; n < 2; ++n) _Pragma("unroll") for (int k = 0; k < 2; ++k) \
        acc[ai][bj][m][n] = __builtin_amdgcn_mfma_f32_16x16x32_bf16(Bt[n][k], At[m][k], acc[ai][bj][m][n], 0, 0, 0); __builtin_amdgcn_s_setprio(0); } while (0)
#if defined(GEMM_DRAIN)
#define PG8_WAIT_V(n) asm volatile("s_waitcnt vmcnt(0)" ::: "memory")
#else
#define PG8_WAIT_V(n) asm volatile("s_waitcnt vmcnt(" #n ")" ::: "memory")
#endif
#define PG8_WAIT_L(n) asm volatile("s_waitcnt lgkmcnt(" #n ")" ::: "memory")
#define PG8_BAR __builtin_amdgcn_s_barrier()
#define PG8_SCHED __builtin_amdgcn_sched_barrier(0)
    Unit cur, nxt; int ui = 0;
    if (!S.next(0, cur)) return;
    f32x4 acc[2][2][4][2];
#pragma unroll
    for (int a = 0; a < 2; ++a)
#pragma unroll
        for (int b = 0; b < 2; ++b)
#pragma unroll
            for (int m = 0; m < 4; ++m)
#pragma unroll
                for (int n = 0; n < 2; ++n) acc[a][b][m][n] = (f32x4){0.f, 0.f, 0.f, 0.f};
    bf16x8 At[4][2], B0[2][2], B1[2][2];
    const char* cA = (const char*)g.A + (size_t)cur.pm * tstep; const char* cB = (const char*)g.Bt + (size_t)cur.pn * tstep;
    S.a_ready(cur);
    if constexpr (SP2) {
        PG8_STAGE(PG8_SB(0, 0), cB, voffB); PG8_STAGE(PG8_SB(0, 1), cB + hstep, voffB); PG8_STAGE(PG8_SA(0, 0), cA, voffA); PG8_STAGE(PG8_SA(0, 1), cA + hstep, voffA);
        if (wr == 1) PG8_BAR;
        PG8_WAIT_V(2); PG8_BAR;
        PG8_STAGE(PG8_SB(1, 0), cB + kstep, voffB); PG8_STAGE(PG8_SA(1, 0), cA + kstep, voffA); PG8_STAGE(PG8_SB(1, 1), cB + hstep + kstep, voffB);
        PG8_WAIT_V(6); PG8_BAR;
    } else {
        PG8_STAGE(PG8_SB(0, 0), cB, voffB); PG8_STAGE(PG8_SA(0, 0), cA, voffA); PG8_STAGE(PG8_SB(0, 1), cB + hstep, voffB); PG8_STAGE(PG8_SA(0, 1), cA + hstep, voffA);
        if (wr == 1) PG8_BAR;
        PG8_WAIT_V(4); PG8_BAR;
        PG8_STAGE(PG8_SB(1, 0), cB + kstep, voffB); PG8_STAGE(PG8_SA(1, 0), cA + kstep, voffA); PG8_STAGE(PG8_SB(1, 1), cB + hstep + kstep, voffB);
        PG8_WAIT_V(6); PG8_BAR;
    }
    for (;;) {
        const bool has_next = S.next(ui + 1, nxt);
        const char* nA = has_next ? (const char*)g.A + (size_t)nxt.pm * tstep : cA; const char* nB = has_next ? (const char*)g.Bt + (size_t)nxt.pn * tstep : cB;
        for (int t = 0; t < nt; t += 2) {
            const bool last = (t == nt - 2);
            const char* a1 = cA + (size_t)(t + 1) * kstep;
            const char* a2 = last ? nA : cA + (size_t)(t + 2) * kstep; const char* b2 = last ? nB : cB + (size_t)(t + 2) * kstep;
            const char* a3 = a2 + kstep; const char* b3 = b2 + kstep;
            if (last && has_next) S.a_ready(nxt);
            if constexpr (SP2) {
            PG8_LDB(B0, 0, 0); PG8_LDB(B1, 0, 1); PG8_SCHED; PG8_LDA(At, 0, 0); PG8_STAGE(PG8_SA(1, 1), a1 + hstep, voffA);
            PG8_WAIT_V(8); PG8_WAIT_L(0); PG8_BAR; PG8_MMA(0, 0, At, B0); PG8_MMA(0, 1, At, B1); PG8_BAR; PG8_SCHED;
            PG8_LDA(At, 0, 1); PG8_STAGE(PG8_SB(0, 0), b2, voffB); PG8_STAGE(PG8_SB(0, 1), b2 + hstep, voffB); PG8_STAGE(PG8_SA(0, 0), a2, voffA);
            PG8_WAIT_V(8); PG8_WAIT_L(0); PG8_BAR; PG8_MMA(1, 0, At, B0); PG8_MMA(1, 1, At, B1); PG8_BAR; PG8_SCHED;
            PG8_LDB(B0, 1, 0); PG8_LDB(B1, 1, 1); PG8_SCHED; PG8_LDA(At, 1, 0); PG8_STAGE(PG8_SA(0, 1), a2 + hstep, voffA);
            PG8_WAIT_V(8); PG8_WAIT_L(0); PG8_BAR; PG8_MMA(0, 0, At, B0); PG8_MMA(0, 1, At, B1); PG8_BAR; PG8_SCHED;
            PG8_LDA(At, 1, 1); PG8_STAGE(PG8_SB(1, 0), b3, voffB); PG8_STAGE(PG8_SB(1, 1), b3 + hstep, voffB); PG8_STAGE(PG8_SA(1, 0), a3, voffA);
            PG8_WAIT_V(8); PG8_WAIT_L(0); PG8_BAR; PG8_MMA(1, 0, At, B0); PG8_MMA(1, 1, At, B1); PG8_BAR; PG8_SCHED;
            } else {
            PG8_LDB(B0, 0, 0); PG8_SCHED; PG8_LDA(At, 0, 0); PG8_STAGE(PG8_SA(1, 1), a1 + hstep, voffA);
            PG8_WAIT_L(8); PG8_BAR; PG8_WAIT_L(0); PG8_MMA(0, 0, At, B0); PG8_BAR; PG8_SCHED;
            PG8_LDB(B1, 0, 1); PG8_STAGE(PG8_SB(0, 0), b2, voffB);
            PG8_BAR; PG8_WAIT_L(0); PG8_MMA(0, 1, At, B1); PG8_BAR;
            PG8_LDA(At, 0, 1); PG8_STAGE(PG8_SA(0, 0), a2, voffA);
            PG8_BAR; PG8_WAIT_L(0); PG8_MMA(1, 0, At, B0); PG8_BAR; PG8_SCHED;
            PG8_STAGE(PG8_SB(0, 1), b2 + hstep, voffB);
            PG8_WAIT_V(6); PG8_BAR; PG8_MMA(1, 1, At, B1); PG8_BAR;
            PG8_LDB(B0, 1, 0); PG8_SCHED; PG8_LDA(At, 1, 0); PG8_STAGE(PG8_SA(0, 1), a2 + hstep, voffA);
            PG8_WAIT_L(8); PG8_BAR; PG8_WAIT_L(0); PG8_MMA(0, 0, At, B0); PG8_BAR; PG8_SCHED;
            PG8_LDB(B1, 1, 1); PG8_STAGE(PG8_SB(1, 0), b3, voffB);
            PG8_BAR; PG8_WAIT_L(0); PG8_MMA(0, 1, At, B1); PG8_BAR;
            PG8_LDA(At, 1, 1); PG8_STAGE(PG8_SA(1, 0), a3, voffA);
            PG8_BAR; PG8_WAIT_L(0); PG8_MMA(1, 0, At, B0); PG8_BAR; PG8_SCHED;
            PG8_STAGE(PG8_SB(1, 1), b3 + hstep, voffB);
            PG8_WAIT_V(6); PG8_BAR; PG8_MMA(1, 1, At, B1); PG8_BAR;
            }
        }
        if constexpr (ALIGN_EPI) { if (wr == 0) PG8_BAR; }
        if constexpr (!Epi::AFTER_DRAIN) { E(acc, cur, wr, wc, fr, fq); S.done(cur); }
        if (!has_next) break;
#pragma unroll
        for (int a = 0; a < 2; ++a)
#pragma unroll
            for (int b = 0; b < 2; ++b)
#pragma unroll
                for (int m = 0; m < 4; ++m)
#pragma unroll
                    for (int n = 0; n < 2; ++n) acc[a][b][m][n] = (f32x4){0.f, 0.f, 0.f, 0.f};
        cur = nxt; cA = nA; cB = nB; ++ui;
        if constexpr (ALIGN_EPI) { if (wr == 1) PG8_BAR; }
    }
    PG8_WAIT_V(0);
    if constexpr (!ALIGN_EPI) { if (wr == 0) PG8_BAR; }
    PG8_BAR;
    if constexpr (Epi::AFTER_DRAIN) { E.fused(acc, cur, wr, wc, fr, fq, lds, wid, lane); S.done(cur); }
#undef PG8_SA
#undef PG8_SB
#undef PG8_STAGE
#undef PG8_LDA
#undef PG8_LDB
#undef PG8_MMA
#undef PG8_WAIT_V
#undef PG8_WAIT_L
#undef PG8_BAR
#undef PG8_SCHED
}
}
#include <hip/hip_bf16.h>
#include <cmath>
namespace attn_body {
using bf16=__hip_bfloat16;
using bf16x8=__attribute__((ext_vector_type(8)))short;
using s16x4=__attribute__((ext_vector_type(4)))short;
using f32x16=__attribute__((ext_vector_type(16)))float;
using u32x4=__attribute__((ext_vector_type(4)))unsigned;
constexpr int BATCH=2,NHEAD=8,SEQ=8192,D=64,DM=NHEAD*D;
constexpr int NW=8,QBLK=32,QB=QBLK*NW,KVBLK=64,NQB=SEQ/QB;
constexpr int ATTN_PITCH=DM, ATTN_UNIT_ROWS=QB;
__device__ __forceinline__ int crow(int r,int hi){return (r&3)+8*(r>>2)+4*hi;}
#define SBAR() __builtin_amdgcn_sched_barrier(0)
__device__ __forceinline__ void cmask(f32x16&p0,f32x16&p1,int jb,int qrel,int hi){
  const float NEG=-INFINITY; int kb=64*jb+4*hi;
  #pragma unroll
  for(int r=0;r<16;++r){int kv=kb+(r&3)+8*(r>>2); if(kv>qrel)p0[r]=NEG; if(kv+32>qrel)p1[r]=NEG;}
}

constexpr int NSLOT=3, SLOTB=8192;
constexpr int LDS_K=0, LDS_V=NSLOT*SLOTB, LDS_WS=2*NSLOT*SLOTB, LDS_OST=LDS_WS+NW*64*4, LDS_BYTES=LDS_OST+NW*4096;
constexpr float C2=0.125f*1.4426950408889634f;
__device__ __forceinline__ void glds16(const void*gsrc,unsigned lds_dst){unsigned keep;
  asm volatile("s_mov_b32 %0, m0\n\ts_mov_b32 m0, %2\n\ts_nop 0\n\tglobal_load_lds_dwordx4 %1, off\n\ts_nop 7\n\ts_nop 7\n\ts_mov_b32 m0, %0":"=&s"(keep):"v"(gsrc),"s"(lds_dst):"memory");}
__device__ __forceinline__ float max3f(float a,float b,float c){float r;asm("v_max3_f32 %0, %1, %2, %3":"=v"(r):"v"(a),"v"(b),"v"(c));return r;}
__device__ __forceinline__ float max2f(float a,float b){float r;asm("v_max_f32_e32 %0, %1, %2":"=v"(r):"v"(a),"v"(b));return r;}
__device__ __forceinline__ float fadd_s(float a,float b){float r;asm("v_add_f32_e32 %0, %1, %2":"=v"(r):"v"(a),"v"(b));return r;}
__device__ __forceinline__ float fsub_s(float a,float b){float r;asm("v_sub_f32_e32 %0, %1, %2":"=v"(r):"v"(a),"v"(b));return r;}
typedef float f32x2_t __attribute__((ext_vector_type(2))); typedef __bf16 bf16x2_t __attribute__((ext_vector_type(2)));
__device__ __forceinline__ unsigned cvtpk_s(float lo,float hi){f32x2_t v={lo,hi};bf16x2_t b=__builtin_convertvector(v,bf16x2_t);return __builtin_bit_cast(unsigned,b);}
#if defined(ATT_DRAIN)
#define WAIT_BAR(N) asm volatile("s_waitcnt vmcnt(0) lgkmcnt(0)\n\ts_barrier":::"memory")
#else
#define WAIT_BAR(N) asm volatile("s_waitcnt vmcnt(" #N ") lgkmcnt(0)\n\ts_barrier":::"memory")
#endif

__device__ __forceinline__ void qkt(f32x16&p0,f32x16&p1,const char*Kslot,const bf16x8*qr,const f32x16&negm,int r32,int hi){
  const char*kb=Kslot+hi*1024+r32*16;
  #pragma unroll
  for(int d0=0;d0<4;++d0){
    const bf16x8 b0=*reinterpret_cast<const bf16x8*>(kb+d0*2048);
    const bf16x8 b1=*reinterpret_cast<const bf16x8*>(kb+d0*2048+512);
    if(d0==0){p0=__builtin_amdgcn_mfma_f32_32x32x16_bf16(b0,qr[0],negm,0,0,0);p1=__builtin_amdgcn_mfma_f32_32x32x16_bf16(b1,qr[0],negm,0,0,0);}
    else{p0=__builtin_amdgcn_mfma_f32_32x32x16_bf16(b0,qr[d0],p0,0,0,0);p1=__builtin_amdgcn_mfma_f32_32x32x16_bf16(b1,qr[d0],p1,0,0,0);}}
}
typedef __attribute__((address_space(3))) const char* lds_cptr;
typedef short v4i16_t __attribute__((ext_vector_type(4)));
__device__ __forceinline__ void kload8(bf16x8*kf,lds_cptr kp){
  kf[0]=*(const __attribute__((address_space(3))) bf16x8*)(kp);      kf[1]=*(const __attribute__((address_space(3))) bf16x8*)(kp+512);
  kf[2]=*(const __attribute__((address_space(3))) bf16x8*)(kp+2048); kf[3]=*(const __attribute__((address_space(3))) bf16x8*)(kp+2560);
  kf[4]=*(const __attribute__((address_space(3))) bf16x8*)(kp+4096); kf[5]=*(const __attribute__((address_space(3))) bf16x8*)(kp+4608);
  kf[6]=*(const __attribute__((address_space(3))) bf16x8*)(kp+6144); kf[7]=*(const __attribute__((address_space(3))) bf16x8*)(kp+6656);
}
__device__ __forceinline__ void kload2(bf16x8*kf,lds_cptr kp,int j){ kf[2*j]=*(const __attribute__((address_space(3))) bf16x8*)(kp+j*2048); kf[2*j+1]=*(const __attribute__((address_space(3))) bf16x8*)(kp+j*2048+512); }
__device__ __forceinline__ s16x4 vtr(lds_cptr p){ return __builtin_bit_cast(s16x4,__builtin_amdgcn_ds_read_tr16_b64_v4i16((__attribute__((address_space(3))) v4i16_t*)p)); }
__device__ __forceinline__ float rowmax(const f32x16&p0,const f32x16&p1){
  float a=max3f(p0[0],p0[1],p1[0]),b=max3f(p0[2],p0[3],p1[1]);a=max3f(a,p1[2],p1[3]);
  #pragma unroll
  for(int r=4;r<16;r+=4){a=max3f(a,p0[r],p0[r+1]);b=max3f(b,p0[r+2],p0[r+3]);a=max3f(a,p1[r],p1[r+1]);b=max3f(b,p1[r+2],p1[r+3]);}
  const float m=max2f(a,b);
  auto rr=__builtin_amdgcn_permlane32_swap(__float_as_uint(m),__float_as_uint(m),false,false);
  return max2f(__uint_as_float(rr[0]),__uint_as_float(rr[1]));
}
__device__ __forceinline__ void pv(f32x16*o,int vb,bf16x8 pa0,bf16x8 pa1,bf16x8 pa2,bf16x8 pa3){
  #pragma unroll
  for(int d0=0;d0<2;++d0){s16x4 lo[4],hi[4];
    #pragma unroll
    for(int ks=0;ks<4;++ks){
      asm volatile("ds_read_b64_tr_b16 %0,%1 offset:%c2":"=&v"(lo[ks]):"v"(vb),"i"(d0*4096+ks*1024):"memory");
      asm volatile("ds_read_b64_tr_b16 %0,%1 offset:%c2":"=&v"(hi[ks]):"v"(vb),"i"(d0*4096+ks*1024+512):"memory");}
    asm volatile("s_waitcnt lgkmcnt(0)":::"memory");SBAR();
    #define PK(k) (bf16x8){lo[k][0],lo[k][1],lo[k][2],lo[k][3],hi[k][0],hi[k][1],hi[k][2],hi[k][3]}
    o[d0]=__builtin_amdgcn_mfma_f32_32x32x16_bf16(pa0,PK(0),o[d0],0,0,0);
    o[d0]=__builtin_amdgcn_mfma_f32_32x32x16_bf16(pa1,PK(1),o[d0],0,0,0);
    o[d0]=__builtin_amdgcn_mfma_f32_32x32x16_bf16(pa2,PK(2),o[d0],0,0,0);
    o[d0]=__builtin_amdgcn_mfma_f32_32x32x16_bf16(pa3,PK(3),o[d0],0,0,0);
    #undef PK
  }
}

#ifndef ATTN_STORE16
#define ATTN_STORE16(p,v) (*(u32x4*)(p)=(v))
#endif
template<int THRL> __device__ __forceinline__ void attn_unit(int b,int h,int qb,const bf16*Q,const bf16*__restrict__ K,const bf16*__restrict__ V,bf16*O,const unsigned long long*MASKG,char*shm){
  const int tid=threadIdx.x,lane=tid&63,r32=lane&31,hi=lane>>5; const int wid=__builtin_amdgcn_readfirstlane(tid>>6);
  const long rowbase=(long)b*SEQ; const int q0=qb*QB;
  const bf16*Qw=Q+(rowbase+q0+wid*QBLK)*DM+h*D;
  const bf16*Kh=K+rowbase*DM+h*D,*Vh=V+rowbase*DM+h*D;
  const unsigned lds0=(unsigned)(uintptr_t)shm;
  float*wsf=(float*)(shm+LDS_WS)+wid*64;
  const bf16*ksrc=Kh+(long)lane*DM+wid*8;
  const bf16*vsrc=Vh+(long)(16*(wid&3)+(lane>>2))*DM+(wid>>2)*32+(lane&3)*8;
  const unsigned kdst=lds0+LDS_K+wid*1024, vdst=lds0+LDS_V+wid*1024;
  #define DMA_K(t,slot) glds16(ksrc+(long)(t)*KVBLK*DM,(unsigned)__builtin_amdgcn_readfirstlane(kdst+(slot)))
  #define DMA_V(t,slot) glds16(vsrc+(long)(t)*KVBLK*DM,(unsigned)__builtin_amdgcn_readfirstlane(vdst+(slot)))
  const int vb0=(int)(lds0+LDS_V)+((lane>>4)&1)*32+(lane&3)*8+(4*hi+((lane&15)>>2))*64;
  const char*Kbase=shm+LDS_K; bf16x8 kf[8];
  const lds_cptr shm3=(lds_cptr)shm; const lds_cptr kp0=shm3+LDS_K+hi*1024+r32*16; const lds_cptr vp0=shm3+LDS_V+((lane>>4)&1)*32+(lane&3)*8+(4*hi+((lane&15)>>2))*64;
  const int NT=(q0+QB)/KVBLK;
  DMA_K(0,0);DMA_V(0,0);DMA_K(1,SLOTB);
  bf16x8 qr[4];
  #pragma unroll
  for(int d0=0;d0<4;++d0)qr[d0]=*reinterpret_cast<const bf16x8*>(&Qw[(long)r32*DM+d0*16+hi*8]);
  float mhat=0.f,l_reg=0.f;f32x16 o[2];o[0]=f32x16{};o[1]=f32x16{};
  const f32x16 zero16=f32x16{};
#if defined(ATT_NOALIBI)
  const float slope2=0.f; const float s32=0.f;
#elif defined(ATT_SMALLSLOPE)
  const float slope2=0.00390625f*1.4426950408889634f; const float s32=32.f*slope2;
#else
  const float slope2=__builtin_amdgcn_exp2f(-(float)(h+1))*1.4426950408889634f; const float s32=32.f*slope2;
#endif
  float kvf=(float)(4*hi-(q0+wid*QBLK+r32));
  bool seen=false;
  const unsigned long long* mrow=MASKG+((size_t)((b*(SEQ/32)+qb*8+wid))*(SEQ/64))*32+r32;
  unsigned long long mw_cur=mrow[0];
  const float NEG=-INFINITY;
  #define MLOAD(t) do{ const int tn_=((t)+1<SEQ/64)?(t)+1:(SEQ/64-1); mw_cur=mrow[(size_t)tn_*32]; }while(0)
#if defined(ATT_DENSE)
  #define ATT_MASKWORD(t) ({ const int d_=(q0+wid*QBLK+r32)-64*(t); (d_>=63)?~0ull:((d_<0)?0ull:((2ull<<d_)-1ull)); })
#else
  #define ATT_MASKWORD(t) (mw_cur)
#endif
  #define MSEL(X,W,c) __builtin_bit_cast(float,(__builtin_bit_cast(unsigned,(X))&(unsigned)(((int)((W)<<(31-(c))))>>31))|(~(unsigned)(((int)((W)<<(31-(c))))>>31)&0xFF800000u))
  #define MASKALIBI(P0,P1,t) do{ const float b0_=__builtin_fmaf(slope2,kvf,-mhat),b1_=b0_+s32; \
    const unsigned long long mwx_=ATT_MASKWORD(t); const unsigned wl_=((unsigned)mwx_)>>(4*hi), wh_=((unsigned)(mwx_>>32))>>(4*hi); \
    _Pragma("unroll") for(int r=0;r<16;++r){ const float x_=P0[r]+__builtin_fmaf(slope2,(float)((r&3)+8*(r>>2)),b0_); P0[r]=MSEL(x_,wl_,(r&3)+8*(r>>2)); } \
    _Pragma("unroll") for(int r=0;r<16;++r){ const float x_=P1[r]+__builtin_fmaf(slope2,(float)((r&3)+8*(r>>2)),b1_); P1[r]=MSEL(x_,wh_,(r&3)+8*(r>>2)); } \
    kvf+=64.f; }while(0)
  #define CMASK(P0,P1,t) MASKALIBI(P0,P1,t)
  bool resc=false;
  #define START(P0,P1) do{ const float rm=rowmax(P0,P1); resc=false; seen=(rm>NEG); \
    { const float dl=seen?rm:0.f; mhat=dl; \
      _Pragma("unroll") for(int r=0;r<16;++r){P0[r]=P0[r]-dl;P1[r]=P1[r]-dl;} } \
    _Pragma("unroll") for(int r=0;r<16;++r)P0[r]=__builtin_amdgcn_exp2f(P0[r]); }while(0)
  #define RESC() do{ if(resc){ asm volatile("s_waitcnt lgkmcnt(0)":::"memory"); \
      _Pragma("unroll") for(int d_=0;d_<2;++d_) _Pragma("unroll") for(int r=0;r<16;++r)o[d_][r]*=wsf[crow(r,hi)]; } }while(0)
  f32x16 pA0,pA1,pB0,pB1;
  int sl_prev=0,sl_cur=0,sl_next=SLOTB;
  #define ROT() do{sl_prev=sl_cur;sl_cur=sl_next;sl_next=(sl_next==(NSLOT-1)*SLOTB)?0:sl_next+SLOTB;}while(0)
  DMA_K(2,2*SLOTB);
  WAIT_BAR(3);
  qkt(pA0,pA1,Kbase,qr,zero16,r32,hi);asm volatile("s_nop 15\n\ts_nop 7":"+v"(pA0),"+v"(pA1));CMASK(pA0,pA1,0);MLOAD(0);
  START(pA0,pA1);
  _Pragma("unroll") for(int r=0;r<16;++r)pA1[r]=__builtin_amdgcn_exp2f(pA1[r]);
  WAIT_BAR(0);
  DMA_K(3,0);DMA_V(1,SLOTB);
  ROT();
  kload8(kf,kp0+sl_cur);
  WAIT_BAR(2);
  s16x4 vlo[8],vhi[8]; u32x4 pw0,pw1,pw2,pw3;
  #define PKW(P,B) cvtpk_s(P[B],P[B+1])
  #define PAF(k) __builtin_bit_cast(bf16x8,pw##k)
  #define VFR(i) (bf16x8){vlo[i][0],vlo[i][1],vlo[i][2],vlo[i][3],vhi[i][0],vhi[i][1],vhi[i][2],vhi[i][3]}
  #define PIN(x) asm volatile("":"+v"(x))
  #define MX3(a,b,c) __builtin_fmaxf(__builtin_fmaxf((a),(b)),(c))
  #define GAPA(MF,A0,A1,A2,A3,W0,W1,PW) do{ MF; sacc+=A0; sacc+=A1; sacc+=A2; sacc+=A3; PIN(sacc); W0; W1; PIN(PW); SBAR(); }while(0)
  #define EX(v) __builtin_amdgcn_exp2f(v)
  #define GAPB(MF,X,B) do{ MF; X[B]=EX(X[B]); X[B+1]=EX(X[B+1]); X[B+2]=EX(X[B+2]); X[B+3]=EX(X[B+3]); PIN(X); SBAR(); }while(0)
  #define VRD(i) do{ vlo[i]=vtr(vp_+(((i)>>2)*4096+((i)&3)*1024)); vhi[i]=vtr(vp_+(((i)>>2)*4096+((i)&3)*1024+512)); }while(0)
  #define KRD(G,j) do{ if(G){ kload2(kf,kp0+sl_next,j); SBAR(); } }while(0)
  #define STEP(C0,C1,P0,P1,t,GK,GV,GL) do{ SBAR(); \
    const lds_cptr vp_=vp0+sl_prev; \
    VRD(0); SBAR(); float sacc=(P0[0]+P0[1]); \
    GAPA(C0=__builtin_amdgcn_mfma_f32_32x32x16_bf16(kf[0],qr[0],zero16,0,0,0), P0[2],P0[3],P0[4],P0[5],     pw0[0]=PKW(P0,0), pw0[1]=PKW(P0,2), pw0); \
    VRD(4); SBAR(); GAPA(C1=__builtin_amdgcn_mfma_f32_32x32x16_bf16(kf[1],qr[0],zero16,0,0,0), P0[6],P0[7],P0[8],P0[9],     pw0[2]=PKW(P0,4), pw0[3]=PKW(P0,6), pw0); \
    VRD(1); SBAR(); GAPA(C0=__builtin_amdgcn_mfma_f32_32x32x16_bf16(kf[2],qr[1],C0,0,0,0),   P0[10],P0[11],P0[12],P0[13], pw1[0]=PKW(P0,8), pw1[1]=PKW(P0,10), pw1); \
    VRD(5); SBAR(); GAPA(C1=__builtin_amdgcn_mfma_f32_32x32x16_bf16(kf[3],qr[1],C1,0,0,0),   P0[14],P0[15],P1[0],P1[1],   pw1[2]=PKW(P0,12),pw1[3]=PKW(P0,14), pw1); \
    VRD(2); SBAR(); GAPA(C0=__builtin_amdgcn_mfma_f32_32x32x16_bf16(kf[4],qr[2],C0,0,0,0),   P1[2],P1[3],P1[4],P1[5],     pw2[0]=PKW(P1,0), pw2[1]=PKW(P1,2), pw2); \
    VRD(6); SBAR(); GAPA(C1=__builtin_amdgcn_mfma_f32_32x32x16_bf16(kf[5],qr[2],C1,0,0,0),   P1[6],P1[7],P1[8],P1[9],     pw2[2]=PKW(P1,4), pw2[3]=PKW(P1,6), pw2); \
    VRD(3); SBAR(); GAPA(C0=__builtin_amdgcn_mfma_f32_32x32x16_bf16(kf[6],qr[3],C0,0,0,0),   P1[10],P1[11],P1[12],P1[13], pw3[0]=PKW(P1,8), pw3[1]=PKW(P1,10), pw3); \
    VRD(7); SBAR(); GAPA(C1=__builtin_amdgcn_mfma_f32_32x32x16_bf16(kf[7],qr[3],C1,0,0,0),   P1[14],P1[15],0.f,0.f,       pw3[2]=PKW(P1,12),pw3[3]=PKW(P1,14), pw3); \
    l_reg+=sacc; \
    CMASK(C0,C1,t); asm volatile("":"+v"(C0),"+v"(C1)); MLOAD(t); \
    if(GK){DMA_K((t)+3,sl_cur);} if(GV){DMA_V((t)+1,sl_next);} \
    { float a=MX3(C0[0],C0[1],C1[0]),b=MX3(C0[2],C0[3],C1[1]); a=MX3(a,C1[2],C1[3]); \
      _Pragma("unroll") for(int r=4;r<16;r+=4){a=MX3(a,C0[r],C0[r+1]);b=MX3(b,C0[r+2],C0[r+3]);a=MX3(a,C1[r],C1[r+1]);b=MX3(b,C1[r+2],C1[r+3]);} \
      float rm=__builtin_fmaxf(a,b); { auto rr=__builtin_amdgcn_permlane32_swap(__float_as_uint(rm),__float_as_uint(rm),false,false); rm=__builtin_fmaxf(__uint_as_float(rr[0]),__uint_as_float(rr[1])); } \
      resc=false; const bool live_=(rm>NEG); \
      if(__any((rm>(float)THRL)||(live_&&!seen&&(rm<-64.f)))){ const float dl=seen?__builtin_fmaxf(rm,0.f):(live_?rm:0.f); mhat+=dl; \
        _Pragma("unroll") for(int r=0;r<16;++r){C0[r]-=dl;C1[r]-=dl;} \
        const float f=seen?__builtin_amdgcn_exp2f(-dl):1.f; l_reg*=f; if(hi==0)wsf[r32]=f; resc=true; } \
      seen=seen||live_; } \
    SBAR(); \
    GAPB(o[0]=__builtin_amdgcn_mfma_f32_32x32x16_bf16(PAF(0),VFR(0),o[0],0,0,0), C0,0); \
    GAPB(o[1]=__builtin_amdgcn_mfma_f32_32x32x16_bf16(PAF(0),VFR(4),o[1],0,0,0), C0,4); \
    KRD(GL,0); GAPB(o[0]=__builtin_amdgcn_mfma_f32_32x32x16_bf16(PAF(1),VFR(1),o[0],0,0,0), C0,8); \
    KRD(GL,1); GAPB(o[1]=__builtin_amdgcn_mfma_f32_32x32x16_bf16(PAF(1),VFR(5),o[1],0,0,0), C0,12); \
    KRD(GL,2); GAPB(o[0]=__builtin_amdgcn_mfma_f32_32x32x16_bf16(PAF(2),VFR(2),o[0],0,0,0), C1,0); \
    KRD(GL,3); GAPB(o[1]=__builtin_amdgcn_mfma_f32_32x32x16_bf16(PAF(2),VFR(6),o[1],0,0,0), C1,4); \
    GAPB(o[0]=__builtin_amdgcn_mfma_f32_32x32x16_bf16(PAF(3),VFR(3),o[0],0,0,0), C1,8); \
    GAPB(o[1]=__builtin_amdgcn_mfma_f32_32x32x16_bf16(PAF(3),VFR(7),o[1],0,0,0), C1,12); \
    }while(0)
  int t=1;
  for(;t+5<NT;t+=2){
    STEP(pB0,pB1,pA0,pA1,t,true,true,true);     WAIT_BAR(2); RESC(); ROT();
    STEP(pA0,pA1,pB0,pB1,t+1,true,true,true);   WAIT_BAR(2); RESC(); ROT();
  }
  #define ENDW(tt) do{ if((tt)+3<NT){WAIT_BAR(2);} else if((tt)+2<NT){WAIT_BAR(1);} else {WAIT_BAR(0);} }while(0)
  for(;t+1<NT;t+=2){
    STEP(pB0,pB1,pA0,pA1,t,(t+3<NT),(t+1<NT),(t+1<NT));       ENDW(t);   RESC(); ROT();
    STEP(pA0,pA1,pB0,pB1,t+1,(t+4<NT),(t+2<NT),(t+2<NT));     ENDW(t+1); RESC(); ROT();
  }
  STEP(pB0,pB1,pA0,pA1,NT-1,false,false,false); RESC();
  { float sacc=pB0[0]+pB0[1]; _Pragma("unroll") for(int r=2;r<16;++r)sacc+=pB0[r]; _Pragma("unroll") for(int r=0;r<16;++r)sacc+=pB1[r]; l_reg+=sacc;
    pw0=(u32x4){PKW(pB0,0),PKW(pB0,2),PKW(pB0,4),PKW(pB0,6)};pw1=(u32x4){PKW(pB0,8),PKW(pB0,10),PKW(pB0,12),PKW(pB0,14)};pw2=(u32x4){PKW(pB1,0),PKW(pB1,2),PKW(pB1,4),PKW(pB1,6)};pw3=(u32x4){PKW(pB1,8),PKW(pB1,10),PKW(pB1,12),PKW(pB1,14)};
    SBAR(); pv(o,vb0+sl_cur,PAF(0),PAF(1),PAF(2),PAF(3)); }
  #undef PKW
  #undef PAF
  #undef VFR
  #undef PIN
  #undef MX3
  #undef GAPA
  #undef GAPB
  #undef EX
  #undef VRD
  #undef KRD
  #undef STEP
  #undef ENDW
  {auto rr=__builtin_amdgcn_permlane32_swap(__float_as_uint(l_reg),__float_as_uint(l_reg),false,false);l_reg=__uint_as_float(rr[0])+__uint_as_float(rr[1]);}
  if(hi==0)wsf[32+r32]=l_reg;asm volatile("s_waitcnt lgkmcnt(0)":::"memory");
  float rli[16];
  #pragma unroll
  for(int r=0;r<16;++r)rli[r]=__builtin_amdgcn_rcpf(wsf[32+crow(r,hi)]);
  bf16*Ow=O+(rowbase+q0+wid*QBLK)*DM+h*D;
  { bf16*stg=(bf16*)(shm+LDS_OST)+wid*2048;
    #pragma unroll
    for(int r=0;r<16;++r){const int orow=crow(r,hi);
      #pragma unroll
      for(int d0=0;d0<2;++d0)stg[orow*64+d0*32+r32]=__float2bfloat16(o[d0][r]*rli[r]);}
    asm volatile("s_waitcnt lgkmcnt(0)":::"memory");
    #pragma unroll
    for(int i=0;i<4;++i){const int row=i*8+(lane>>3),ch=lane&7; const u32x4 v=*(const u32x4*)(stg+row*64+ch*8); ATTN_STORE16(Ow+(long)row*DM+ch*8,v);} }
  asm volatile("s_waitcnt lgkmcnt(0)\n\ts_barrier":::"memory");
  #undef DMA_K
  #undef DMA_V
  #undef CMASK
  #undef MASKALIBI
  #undef MLOAD
  #undef MSEL
  #undef START
  #undef RESC
  #undef ROT
}
constexpr int ATTN_LDS_BYTES=LDS_BYTES;
struct AttnTensors { const bf16* Q; const bf16* K; const bf16* V; bf16* O; const unsigned long long* MASK; };
struct AttnUnit { int bh; int qb; };
struct StaticOrder {
  int vcu;
  __device__ __forceinline__ explicit StaticOrder(int grid,int block):vcu((block%8)*(grid/8)+block/8){}
  __device__ __forceinline__ bool next(int i,AttnUnit&u)const{ if(i>=2)return false; const int s=vcu&15; u.bh=vcu>>4; u.qb=(i==0)?s:31-s; return true; }
  __device__ __forceinline__ void a_ready(const AttnUnit&)const{}
  __device__ __forceinline__ void done(const AttnUnit&)const{}
};
template<class Sched,int THRL=8> __device__ __forceinline__ void attn_phase(char*lds,const AttnTensors&T,const Sched&S){
  AttnUnit u;
  for(int i=0;S.next(i,u);++i){ S.a_ready(u); attn_unit<THRL>(u.bh/NHEAD,u.bh%NHEAD,u.qb,T.Q,T.K,T.V,T.O,T.MASK,lds); S.done(u); }
}
#undef SBAR
#undef WAIT_BAR
}
namespace idx_body {
using bf16x8 = __attribute__((ext_vector_type(8))) short;
using f32x16 = __attribute__((ext_vector_type(16))) float;
using u32x4 = __attribute__((ext_vector_type(4))) unsigned;
typedef __attribute__((address_space(3))) unsigned lds_u32;
constexpr int SEQ = 8192, CAP = 1024, TOPK = 256, HW = CAP - 128, SLOTB = 8192;
constexpr int LDS_RING = 0, LDS_LIST = 2 * SLOTB, LDS_FLAG = LDS_LIST + 32 * CAP * 4, LDS_BYTES = LDS_FLAG + 64;
__device__ __forceinline__ unsigned ord_key(float s) { const unsigned b = __builtin_bit_cast(unsigned, s); return b ^ ((unsigned)((int)b >> 31) | 0x80000000u); }
__device__ __forceinline__ float ord_floor_to_float(unsigned T) {
    const unsigned o = T & 0xFFFFE000u; if (o <= 0x007FFFFFu) return -INFINITY;
    const unsigned b = (o & 0x80000000u) ? (o ^ 0x80000000u) : ~o; return __builtin_bit_cast(float, b);
}
__device__ __forceinline__ int wave_select(lds_u32* lst, int cnt, int target_hi, int lane, unsigned* Tout) {
    unsigned e[CAP / 64];
#pragma unroll
    for (int j = 0; j < CAP / 64; ++j) e[j] = (j * 64 + lane < cnt) ? lst[j * 64 + lane] : 0u;
    unsigned T = 0u; int cT = cnt;
    for (int bit = 31; bit >= 0 && cT > target_hi; --bit) {
        const unsigned cand = T | (1u << bit); int c = 0;
#pragma unroll
        for (int j = 0; j < CAP / 64; ++j) c += __builtin_popcountll(__ballot(e[j] >= cand));
        if (c >= TOPK) { T = cand; cT = c; }
    }
    asm volatile("s_waitcnt lgkmcnt(0)" ::: "memory");
    int base = 0;
#pragma unroll
    for (int j = 0; j < CAP / 64; ++j) { const bool k = (e[j] >= T) && (e[j] != 0u); const unsigned long long m = __ballot(k);
        if (k) lst[base + __builtin_popcountll(m & ((1ull << lane) - 1ull))] = e[j];
        base += __builtin_popcountll(m); }
    *Tout = T; return base;
}
__device__ __forceinline__ void glds16(const void* gsrc, unsigned lds_dst) { unsigned keep;
    asm volatile("s_mov_b32 %0, m0\n\ts_mov_b32 m0, %2\n\ts_nop 0\n\tglobal_load_lds_dwordx4 %1, off\n\ts_mov_b32 m0, %0" : "=&s"(keep) : "v"(gsrc), "s"(lds_dst) : "memory"); }

__device__ __forceinline__ void idx_unit(int b, int qb, const unsigned short* QI, const unsigned short* KI, const float* WI, unsigned* MASK, char* shm, unsigned* dbg = nullptr) {
    const int tid = threadIdx.x, lane = tid & 63, r32 = lane & 31, hi = lane >> 5; const int wid = __builtin_amdgcn_readfirstlane(tid >> 6);
    const long rowbase = (long)b * SEQ; const int q0 = qb * 32;
    const unsigned lds0 = (unsigned)(uintptr_t)shm;
    lds_u32* lists = (lds_u32*)(__attribute__((address_space(3))) char*)(shm + LDS_LIST);
    lds_u32* flag = (lds_u32*)(__attribute__((address_space(3))) char*)(shm + LDS_FLAG);
    bf16x8 aq[4];
    { const unsigned short* qp = QI + (rowbase + q0 + 4 * wid + (r32 >> 3)) * 512 + (r32 & 7) * 64 + hi * 8;
#pragma unroll
      for (int ks = 0; ks < 4; ++ks) aq[ks] = *(const bf16x8*)(qp + ks * 16); }
    float wv[16];
#pragma unroll
    for (int g = 0; g < 4; ++g)
#pragma unroll
        for (int i = 0; i < 4; ++i) wv[4 * g + i] = WI[(rowbase + q0 + 4 * wid + g) * 8 + 4 * hi + i];
    const int NT = ((q0 + 31) >> 6) + 1;
    const unsigned short* ksrc = KI + (rowbase + lane) * 64 + wid * 8;
    const unsigned kdst = lds0 + LDS_RING + wid * 1024;
    int cnt0 = 0, cnt1 = 0, cnt2 = 0, cnt3 = 0;
    float tf0 = -INFINITY, tf1 = -INFINITY, tf2 = -INFINITY, tf3 = -INFINITY;
    const int qposA = q0 + 4 * wid + (hi ? 2 : 0), qposB = qposA + 1;
    lds_u32* listA = lists + (4 * wid + (hi ? 2 : 0)) * CAP; lds_u32* listB = listA + CAP;
    if (tid == 0) { flag[0] = 0u; flag[1] = 0u; }
    glds16(ksrc, (unsigned)__builtin_amdgcn_readfirstlane(kdst));
    bool need = false;
    for (int t = 0; t < NT; ++t) {
        asm volatile("s_waitcnt vmcnt(0)" ::: "memory");
        __syncthreads();
        if (t + 1 < NT) glds16(ksrc + (long)(t + 1) * 64 * 64, (unsigned)__builtin_amdgcn_readfirstlane(kdst + ((t + 1) & 1) * SLOTB));
        if (t > 0) {
            const bool go = need || (flag[(t - 1) & 1] == (unsigned)t);
            if (go) {
                unsigned T;
                if (cnt0 > 384) { cnt0 = wave_select(lists + (4 * wid + 0) * CAP, cnt0, 320, lane, &T); tf0 = ord_floor_to_float(T); }
                if (cnt1 > 384) { cnt1 = wave_select(lists + (4 * wid + 1) * CAP, cnt1, 320, lane, &T); tf1 = ord_floor_to_float(T); }
                if (cnt2 > 384) { cnt2 = wave_select(lists + (4 * wid + 2) * CAP, cnt2, 320, lane, &T); tf2 = ord_floor_to_float(T); }
                if (cnt3 > 384) { cnt3 = wave_select(lists + (4 * wid + 3) * CAP, cnt3, 320, lane, &T); tf3 = ord_floor_to_float(T); }
            }
        }
#if defined(IDX_NOFILTER)
        const float tauA = -INFINITY, tauB = -INFINITY;
#else
        const float tauA = hi ? tf2 : tf0, tauB = hi ? tf3 : tf1;
#endif
        const __attribute__((address_space(3))) char* slot = (const __attribute__((address_space(3))) char*)(shm + LDS_RING + (t & 1) * SLOTB) + hi * 1024 + r32 * 16;
#pragma unroll
        for (int p = 0; p < 2; ++p) {
            f32x16 acc = f32x16{};
#pragma unroll
            for (int ks = 0; ks < 4; ++ks) { const bf16x8 kb = *(const __attribute__((address_space(3))) bf16x8*)(slot + ks * 2048 + p * 512);
                acc = __builtin_amdgcn_mfma_f32_32x32x16_bf16(aq[ks], kb, acc, 0, 0, 0); }
#if defined(IDX_DBG)
            if ((IDX_DBG & 32) && t == (NT > 3 ? 3 : 0)) {
                const size_t kr = (size_t)(rowbase + 64 * t + 32 * p + r32); bool bad = false;
#pragma unroll
                for (int g = 0; g < 4; ++g)
#pragma unroll
                    for (int i = 0; i < 4; ++i) { const size_t qa = (size_t)(rowbase + q0 + 4 * wid + g); float d = 0.f;
                        for (int k = 0; k < 64; ++k) d = __builtin_fmaf(__builtin_bit_cast(float, (unsigned)QI[qa * 512 + (4 * hi + i) * 64 + k] << 16), __builtin_bit_cast(float, (unsigned)KI[kr * 64 + k] << 16), d);
                        bad |= !(fabsf(acc[4 * g + i] - d) <= 1e-3f * fabsf(d) + 1e-2f); }
                if (bad) __hip_atomic_store(dbg, 1u, __ATOMIC_RELAXED, __HIP_MEMORY_SCOPE_AGENT); }
#endif
            float P[4];
#pragma unroll
            for (int g = 0; g < 4; ++g) { float s = wv[4 * g] * __builtin_fmaxf(acc[4 * g], 0.f);
#pragma unroll
                for (int i = 1; i < 4; ++i) s = __builtin_fmaf(wv[4 * g + i], __builtin_fmaxf(acc[4 * g + i], 0.f), s);
                P[g] = s; }
#if defined(IDX_SHFL)
            const float F0 = P[0] + __shfl_xor(P[0], 32), F1 = P[1] + __shfl_xor(P[1], 32), F2 = P[2] + __shfl_xor(P[2], 32), F3 = P[3] + __shfl_xor(P[3], 32);
            const float SA = hi ? F2 : F0, SB = hi ? F3 : F1;
#else
            const auto rA = __builtin_amdgcn_permlane32_swap(__builtin_bit_cast(unsigned, P[0]), __builtin_bit_cast(unsigned, P[2]), false, false);
            const auto rB = __builtin_amdgcn_permlane32_swap(__builtin_bit_cast(unsigned, P[1]), __builtin_bit_cast(unsigned, P[3]), false, false);
            const float SA = __builtin_bit_cast(float, rA[0]) + __builtin_bit_cast(float, rA[1]);
            const float SB = __builtin_bit_cast(float, rB[0]) + __builtin_bit_cast(float, rB[1]);
#endif
            const int kk = 64 * t + 32 * p + r32;
#if defined(IDX_DBG)
            if ((IDX_DBG & 16) && t == (NT > 3 ? 3 : 0)) {
                const size_t qa = (size_t)(rowbase + qposA), kr = (size_t)(rowbase + kk); float ea = 0.f, eb = 0.f;
                for (int j = 0; j < 8; ++j) { float da = 0.f, db = 0.f;
                    for (int k = 0; k < 64; ++k) { const float kv = __builtin_bit_cast(float, (unsigned)KI[kr * 64 + k] << 16);
                        da = __builtin_fmaf(__builtin_bit_cast(float, (unsigned)QI[qa * 512 + j * 64 + k] << 16), kv, da); db = __builtin_fmaf(__builtin_bit_cast(float, (unsigned)QI[(qa + 1) * 512 + j * 64 + k] << 16), kv, db); }
                    ea = __builtin_fmaf(WI[qa * 8 + j], __builtin_fmaxf(da, 0.f), ea); eb = __builtin_fmaf(WI[(qa + 1) * 8 + j], __builtin_fmaxf(db, 0.f), eb); }
                const bool bad = !(fabsf(SA - ea) <= 1e-3f * fabsf(ea) + 1e-2f) || !(fabsf(SB - eb) <= 1e-3f * fabsf(eb) + 1e-2f);
                if (bad) __hip_atomic_store(dbg, 1u, __ATOMIC_RELAXED, __HIP_MEMORY_SCOPE_AGENT); }
#endif
            const bool pa = (SA >= tauA) && (kk <= qposA), pb = (SB >= tauB) && (kk <= qposB);
            const unsigned long long ma = __ballot(pa), mb = __ballot(pb);
            if (ma | mb) {
                const unsigned below = (1u << r32) - 1u;
                const unsigned ha = hi ? (unsigned)(ma >> 32) : (unsigned)ma, hb = hi ? (unsigned)(mb >> 32) : (unsigned)mb;
                const int posA = (hi ? cnt2 : cnt0) + __builtin_popcount(ha & below), posB = (hi ? cnt3 : cnt1) + __builtin_popcount(hb & below);
                const unsigned kidx = (unsigned)(8191 - kk);
                if (pa && posA < CAP) listA[posA] = (ord_key(SA) & 0xFFFFE000u) | kidx;
                if (pb && posB < CAP) listB[posB] = (ord_key(SB) & 0xFFFFE000u) | kidx;
                cnt0 += __builtin_popcount((unsigned)ma); cnt2 += __builtin_popcount((unsigned)(ma >> 32));
                cnt1 += __builtin_popcount((unsigned)mb); cnt3 += __builtin_popcount((unsigned)(mb >> 32));
            }
        }
        const int mx = max(max(cnt0, cnt1), max(cnt2, cnt3));
        need = mx > HW;
        if (need && lane == 0) flag[t & 1] = (unsigned)(t + 1);
    }
    asm volatile("s_waitcnt lgkmcnt(0)" ::: "memory");
    { unsigned T;
      if (cnt0 > TOPK) cnt0 = wave_select(lists + (4 * wid + 0) * CAP, cnt0, TOPK, lane, &T);
      if (cnt1 > TOPK) cnt1 = wave_select(lists + (4 * wid + 1) * CAP, cnt1, TOPK, lane, &T);
      if (cnt2 > TOPK) cnt2 = wave_select(lists + (4 * wid + 2) * CAP, cnt2, TOPK, lane, &T);
      if (cnt3 > TOPK) cnt3 = wave_select(lists + (4 * wid + 3) * CAP, cnt3, TOPK, lane, &T); }
    asm volatile("s_waitcnt lgkmcnt(0)" ::: "memory");
#if defined(IDX_DBG)
    { const int w0 = min(TOPK, q0 + 4 * wid + 0 + 1), w1 = min(TOPK, q0 + 4 * wid + 1 + 1), w2 = min(TOPK, q0 + 4 * wid + 2 + 1), w3 = min(TOPK, q0 + 4 * wid + 3 + 1);
      if ((IDX_DBG & 4) && (cnt0 > w0 || cnt1 > w1 || cnt2 > w2 || cnt3 > w3) && lane == 0) __hip_atomic_store(dbg, 1u, __ATOMIC_RELAXED, __HIP_MEMORY_SCOPE_AGENT);
      if ((IDX_DBG & 8) && (cnt0 < w0 || cnt1 < w1 || cnt2 < w2 || cnt3 < w3) && lane == 0) __hip_atomic_store(dbg, 1u, __ATOMIC_RELAXED, __HIP_MEMORY_SCOPE_AGENT);
      if ((IDX_DBG & 1) && (cnt0 != w0 || cnt1 != w1 || cnt2 != w2 || cnt3 != w3) && lane == 0) __hip_atomic_store(dbg, 1u, __ATOMIC_RELAXED, __HIP_MEMORY_SCOPE_AGENT); }
#endif
    unsigned ent[4][4];
#pragma unroll
    for (int g = 0; g < 4; ++g) { const int c = (g == 0) ? cnt0 : (g == 1) ? cnt1 : (g == 2) ? cnt2 : cnt3; const int cc = c < TOPK ? c : TOPK;
#pragma unroll
        for (int j = 0; j < 4; ++j) ent[g][j] = (j * 64 + lane < cc) ? lists[(4 * wid + g) * CAP + j * 64 + lane] : 0xFFFFFFFFu; }
    asm volatile("s_waitcnt lgkmcnt(0)" ::: "memory");
    __syncthreads();
    lds_u32* img = lists;
#pragma unroll
    for (int i = 0; i < 4; ++i) *(__attribute__((address_space(3))) u32x4*)(img + (i * 512 + tid) * 4) = (u32x4){0u, 0u, 0u, 0u};
    asm volatile("s_waitcnt lgkmcnt(0)" ::: "memory");
    __syncthreads();
#pragma unroll
    for (int g = 0; g < 4; ++g)
#pragma unroll
        for (int j = 0; j < 4; ++j) if (ent[g][j] != 0xFFFFFFFFu) {
            const int kk = 8191 - (int)(ent[g][j] & 0x1FFFu); const int tt = kk >> 6, kl = kk & 63;
            __hip_atomic_fetch_or(img + tt * 64 + (4 * wid + g) * 2 + (kl >> 5), 1u << (kl & 31), __ATOMIC_RELAXED, __HIP_MEMORY_SCOPE_WORKGROUP); }
    asm volatile("s_waitcnt lgkmcnt(0)" ::: "memory");
    __syncthreads();
#if defined(IDX_DBG)
    if (IDX_DBG & 2) {
        const int row = tid & 31, part = tid >> 5; int pc = 0;
        for (int tt = part * 8; tt < part * 8 + 8; ++tt) pc += __builtin_popcount(img[tt * 64 + row * 2]) + __builtin_popcount(img[tt * 64 + row * 2 + 1]);
        lds_u32* accp = (lds_u32*)(__attribute__((address_space(3))) char*)(shm + LDS_RING);
        if (tid < 32) accp[tid] = 0u;
        __syncthreads();
        __hip_atomic_fetch_add(accp + row, (unsigned)pc, __ATOMIC_RELAXED, __HIP_MEMORY_SCOPE_WORKGROUP);
        __syncthreads();
        if (tid < 32) { const int want = min(TOPK, q0 + tid + 1); if ((int)accp[tid] != want) __hip_atomic_store(dbg, 1u, __ATOMIC_RELAXED, __HIP_MEMORY_SCOPE_AGENT); }
        __syncthreads(); }
#endif
    { unsigned* dst = MASK + ((size_t)(b * (SEQ / 32) + qb) * (SEQ / 64)) * 64;
#pragma unroll
      for (int i = 0; i < 4; ++i) { const u32x4 v = *(const __attribute__((address_space(3))) u32x4*)(img + (i * 512 + tid) * 4); *(u32x4*)(dst + (i * 512 + tid) * 4) = v; } }
    asm volatile("s_waitcnt lgkmcnt(0)" ::: "memory");
    __syncthreads();
}
}

#ifndef ATT_THRL
#define ATT_THRL 8
#endif
#ifndef CNT_THRESH
#define CNT_THRESH 64
#endif
#ifndef CHECK14_LAUNCH
#define CHECK14_LAUNCH 0
#endif
#ifndef CHK14_ROW0
#define CHK14_ROW0 4096
#endif
#ifndef CHK14_BUF
#define CHK14_BUF SGA
#define CHK14_COL 3144
#endif
#ifndef P2_ALIGN
#define P2_ALIGN true
#endif
#ifndef P2_SP2
#define P2_SP2 true
#endif
#ifndef CHK19_ROW0
#define CHK19_ROW0 0
#define CHK19_NROW 16384
#endif
#ifndef CHK19_COL0
#define CHK19_COL0 0
#define CHK19_NCOL 1024
#endif
#ifndef CHK19_REL
#define CHK19_REL 2e-2f
#define CHK19_ABS 1e-2f
#endif
constexpr int NWAVES = 8;
constexpr int BATCH = 2, T = 8192, D = 1024, NH = 8, HD = 64, AW = 512, CC = 512, CWID = 31, DFF = 2816, NMOD = 6;
constexpr int M = BATCH * T;
constexpr int NIN = 5192, NIN_PAD = 5376;
constexpr int NFF1 = 2 * DFF;
constexpr float EPS = 1e-6f;
constexpr size_t MiB = 1u << 20;
constexpr size_t WS_CTL = 0, CTL_ZERO_BYTES = 1 * MiB;
constexpr size_t WS_WIN = 1 * MiB;
constexpr size_t WS_WAP = 12 * MiB;
constexpr size_t WS_WCP = 13 * MiB;
constexpr size_t WS_WOUT = 14 * MiB;
constexpr size_t WS_WFF1 = 16 * MiB;
constexpr size_t WS_WFF2 = 28 * MiB;
constexpr size_t WS_MOD = 34 * MiB;
constexpr size_t WS_MODP = 34 * MiB + 65536;
constexpr size_t WS_KI = 35 * MiB;
constexpr size_t WS_WI = 37 * MiB;
constexpr size_t WS_XN = 38 * MiB;
constexpr size_t WS_Q = 70 * MiB;
constexpr size_t WS_K = 86 * MiB;
constexpr size_t WS_V = 102 * MiB;
constexpr size_t WS_QI = 118 * MiB;
constexpr size_t WS_Z = 134 * MiB;
constexpr size_t WS_SGA = 150 * MiB;
constexpr size_t WS_SGB = 182 * MiB;
constexpr size_t WS_MASK = 214 * MiB;
constexpr size_t WS_CO = 230 * MiB;
constexpr size_t WS_MERGED = WS_XN;
constexpr size_t WS_XN2 = WS_Q;
constexpr size_t WS_H = WS_V;
constexpr size_t WS_END = 256 * MiB;
static_assert(WS_H + (size_t)M * DFF * 2 <= WS_MASK + 16 * MiB && WS_CO + (size_t)M * 512 * 2 <= WS_END, "d_ws map");
constexpr int CW_TMO = 0, CW_CODE = 1, CW_CHK = 2;
constexpr int CW_BAR = 4096;
constexpr int RING_OFF = 0, RING_BYTES = 147456;
constexpr int LDSCTL_OFF = RING_BYTES + 256, MISC_OFF = LDSCTL_OFF + 320;
constexpr int LDS_BYTES = LDSCTL_OFF + 1024;
static_assert(idx_body::LDS_BYTES <= LDSCTL_OFF && MISC_OFF + 128 <= LDS_BYTES && LDS_BYTES <= 163840, "LDS map");

#define GAS __attribute__((address_space(1)))
#define LAS __attribute__((address_space(3)))
typedef unsigned short bf16;
typedef unsigned v4u __attribute__((ext_vector_type(4)));
typedef float f32x4 __attribute__((ext_vector_type(4)));
typedef short bf16x8 __attribute__((ext_vector_type(8)));
typedef GAS unsigned gu32;
typedef GAS unsigned long long gu64;
#define RLX_AGENT __ATOMIC_RELAXED, __HIP_MEMORY_SCOPE_AGENT
#define LDS_WAIT() asm volatile("s_waitcnt lgkmcnt(0)" ::: "memory")
#define VM_WAIT() asm volatile("s_waitcnt vmcnt(0)" ::: "memory")
__device__ __forceinline__ unsigned long long rt() { return __builtin_amdgcn_s_memrealtime(); }
__device__ __forceinline__ unsigned f2bf(float f) { unsigned u = __builtin_bit_cast(unsigned, f); return (u + 0x7fffu + ((u >> 16) & 1u)) >> 16; }
__device__ __forceinline__ unsigned pk2(float lo, float hi) { return f2bf(lo) | (f2bf(hi) << 16); }

#define XB_TMO      128
#define XB_XCNT(j)  (256  + 64 * (j))
#define XB_XSUB(j)  (1280 + 64 * (j))
#define XB_XGEN(j)  (2304 + 64 * (j))
#define XB_TOP      3328
#define XB_TOPGEN   3392
#define XCD_BAR_WORDS 3456
#define XB_SPIN_CAP (1u << 18)

__device__ __forceinline__ unsigned xb_ld(unsigned* p)              { return __hip_atomic_load(p, __ATOMIC_RELAXED, __HIP_MEMORY_SCOPE_AGENT); }
__device__ __forceinline__ unsigned xb_add(unsigned* p, unsigned v) { return __hip_atomic_fetch_add(p, v, __ATOMIC_RELAXED, __HIP_MEMORY_SCOPE_AGENT); }
__device__ __forceinline__ unsigned xb_xcc_id() { return (unsigned)__builtin_amdgcn_s_getreg((3 << 11) | 20) & 0xFu; }
#define XB_SPIN(cond, bar) do { unsigned _sp = 0; while (cond) { __builtin_amdgcn_s_sleep(1); \
    if ((++_sp & 255u) == 0u) { if (xb_ld(&(bar)[XB_TMO])) break; if (_sp > XB_SPIN_CAP) { atomicAdd(&(bar)[XB_TMO], 1u); break; } } } } while (0)

#if defined(SYS_FENCE)
#define BAR_FENCE_REL() __builtin_amdgcn_fence(__ATOMIC_RELEASE, "")
#define BAR_FENCE_ACQ() __builtin_amdgcn_fence(__ATOMIC_ACQUIRE, "")
#else
#define BAR_FENCE_REL() __builtin_amdgcn_fence(__ATOMIC_RELEASE, "agent")
#define BAR_FENCE_ACQ() __builtin_amdgcn_fence(__ATOMIC_ACQUIRE, "agent")
#endif
struct XcdBarrier {
    unsigned* bar; unsigned x;
    volatile LAS unsigned* st;
};

__device__ __forceinline__ XcdBarrier xcd_barrier_post(unsigned* bar, volatile LAS unsigned* st) {
    XcdBarrier b; b.bar = bar; b.x = xb_xcc_id(); b.st = st;
    if (threadIdx.x == 0) (void)xb_add(&bar[XB_XCNT(b.x)], 1u);
    return b;
}
__device__ __forceinline__ void xcd_barrier_complete(unsigned* bar, unsigned x, unsigned& nloc, unsigned& nx) {
    const unsigned G = gridDim.x * gridDim.y * gridDim.z;
    unsigned sum, cnt, mine, sp = 0u;
    for (;;) {
        sum = 0u; cnt = 0u; mine = 0u;
#pragma unroll
        for (unsigned j = 0; j < 16; ++j) { const unsigned c = xb_ld(&bar[XB_XCNT(j)]); sum += c; cnt += (c > 0u) ? 1u : 0u; mine = (j == x) ? c : mine; }
        if (sum == G) break;
        __builtin_amdgcn_s_sleep(1);
        if ((++sp & 255u) == 0u) { if (xb_ld(&bar[XB_TMO])) break; if (sp > XB_SPIN_CAP) { atomicAdd(&bar[XB_TMO], 1u); break; } }
    }
    nloc = mine > 0u ? mine : 1u; nx = cnt > 0u ? cnt : 1u;
}

__device__ __forceinline__ void xcd_barrier(const XcdBarrier& b) {
#if defined(BAR_DELAY)
    asm volatile("s_waitcnt vmcnt(0)" ::: "memory"); { const unsigned long long t0_ = __builtin_amdgcn_s_memrealtime(); while (__builtin_amdgcn_s_memrealtime() - t0_ < (unsigned long long)BAR_DELAY) __builtin_amdgcn_s_sleep(8); }
#endif
#if defined(STRONG_FENCE)
    __threadfence();
#endif
    asm volatile("s_waitcnt vmcnt(0)" ::: "memory");
    __syncthreads();
    if (threadIdx.x == 0) {
        unsigned* bar = b.bar;
        __builtin_amdgcn_s_waitcnt(0);
        unsigned nloc = b.st[0], nx = b.st[1];
        if (nloc == 0u) { xcd_barrier_complete(bar, b.x, nloc, nx); b.st[0] = nloc; b.st[1] = nx; }
        const unsigned old = xb_add(&bar[XB_XSUB(b.x)], 1u);
        const unsigned gen = old / nloc;
        if (old + 1u == (gen + 1u) * nloc) {
            BAR_FENCE_REL();
            asm volatile("s_waitcnt vmcnt(0)" ::: "memory");
            const unsigned og = xb_add(&bar[XB_TOP], 1u);
            const unsigned tg = og / nx;
            if (og + 1u == (tg + 1u) * nx) xb_add(&bar[XB_TOPGEN], 1u);
            else XB_SPIN(xb_ld(&bar[XB_TOPGEN]) == tg, bar);
            BAR_FENCE_ACQ();
            xb_add(&bar[XB_XGEN(b.x)], 1u);
            asm volatile("s_waitcnt vmcnt(0)" ::: "memory");
        } else {
            XB_SPIN(xb_ld(&bar[XB_XGEN(b.x)]) == gen, bar);
            BAR_FENCE_ACQ();
            asm volatile("s_waitcnt vmcnt(0)" ::: "memory");
        }
    }
    __syncthreads();
#if defined(STRONG_FENCE)
    __threadfence();
#endif
}
__device__ __forceinline__ float bflo(unsigned w) { return __builtin_bit_cast(float, w << 16); }
__device__ __forceinline__ float bfhi(unsigned w) { return __builtin_bit_cast(float, w & 0xffff0000u); }

struct Frame {
    LAS unsigned char* lds;
    volatile LAS unsigned* MISC;
    gu32* ctl;
    int tid, lane, wave;
    int vcu, G;
};
__device__ __forceinline__ float wave_sum(float v) {
#pragma unroll
    for (int o = 1; o < 64; o <<= 1) v += __shfl_xor(v, o);
    return v;
}
__device__ __forceinline__ float sigmf(float x) { return __builtin_amdgcn_rcpf(1.0f + __builtin_amdgcn_exp2f(-1.4426950408889634f * x)); }
__device__ __forceinline__ void p0_transpose_item(const float* W, int K, int N, bf16* WT, int kb, int dr0, int sc0, int nvalid, LAS float* scr, int lane) {
    const int k0 = 64 * kb; const int cl = lane & 31; const bool ok = (sc0 >= 0) && (cl < nvalid);
#pragma unroll 8
    for (int i = 0; i < 32; ++i) { const int kk = 2 * i + (lane >> 5); scr[kk * 33 + cl] = ok ? W[(size_t)(k0 + kk) * N + sc0 + cl] : 0.f; }
    LDS_WAIT(); asm volatile("" ::: "memory");
    const int c = lane & 7;
#pragma unroll
    for (int j = 0; j < 4; ++j) { const int n = (lane >> 3) + 8 * j; const LAS float* s = scr + (8 * c) * 33 + n;
        v4u o; o.x = pk2(s[0 * 33], s[1 * 33]); o.y = pk2(s[2 * 33], s[3 * 33]); o.z = pk2(s[4 * 33], s[5 * 33]); o.w = pk2(s[6 * 33], s[7 * 33]);
        *(GAS v4u*)(WT + (size_t)(dr0 + n) * K + k0 + 8 * c) = o; }
    LDS_WAIT(); asm volatile("" ::: "memory");
}
__device__ __forceinline__ void win_map(int dr0, int& sc0, int& nv) {
    nv = 32;
    if (dr0 < 2048) sc0 = dr0;
    else if (dr0 < 3072) { const int j = (dr0 - 2048) >> 8, w = (dr0 - 2048) & 255;
        sc0 = (w < 128) ? (2120 + 128 * j + w) : (2632 + 128 * j + (w - 128)); }
    else if (dr0 < 4096) sc0 = 3144 + (dr0 - 3072);
    else if (dr0 < 5120) sc0 = 4168 + (dr0 - 4096);
    else if (dr0 < 5184) sc0 = 2048 + (dr0 - 5120);
    else if (dr0 == 5184) { sc0 = 2112; nv = 8; }
    else sc0 = -1;
}
__device__ __forceinline__ void ff1_map(int dr0, int& sc0, int& nv) {
    nv = 32; const int j = dr0 >> 8, w = dr0 & 255; sc0 = (w < 128) ? (128 * j + w) : (DFF + 128 * j + (w - 128));
}
__device__ __forceinline__ void rms_row_to_bf16(const float* xrow, bf16* orow, const LAS float* A, const LAS float* Bv, int lane) {
    const GAS f32x4* xr = (const GAS f32x4*)xrow + lane;
    f32x4 v[4]; float s2 = 0.f;
#pragma unroll
    for (int j = 0; j < 4; ++j) { v[j] = xr[64 * j]; s2 += (v[j].x * v[j].x + v[j].y * v[j].y) + (v[j].z * v[j].z + v[j].w * v[j].w); }
    const float rstd = 1.f / sqrtf(wave_sum(s2) * (1.f / D) + EPS);
    GAS unsigned long long* o8 = (GAS unsigned long long*)orow + lane;
#pragma unroll
    for (int j = 0; j < 4; ++j) { const f32x4 a = *(const LAS f32x4*)(A + 4 * lane + 256 * j), bb = *(const LAS f32x4*)(Bv + 4 * lane + 256 * j);
        const f32x4 y = v[j] * rstd * a + bb;
        o8[64 * j] = (unsigned long long)pk2(y.x, y.y) | ((unsigned long long)pk2(y.z, y.w) << 32); }
}
__device__ __forceinline__ void conv_item(int m0, const bf16* Z, const LAS float* wl  , const float* b_dw, const float* ln_g, const float* ln_b, bf16* CO, int lane) {
    const int t0 = m0 & (T - 1); const size_t bbase = (size_t)(m0 - t0);
    float acc[8][8];
    { const f32x4 b0 = *(const f32x4*)(b_dw + 8 * lane), b1 = *(const f32x4*)(b_dw + 8 * lane + 4);
#pragma unroll
      for (int tt = 0; tt < 8; ++tt) { acc[tt][0] = b0.x; acc[tt][1] = b0.y; acc[tt][2] = b0.z; acc[tt][3] = b0.w; acc[tt][4] = b1.x; acc[tt][5] = b1.y; acc[tt][6] = b1.z; acc[tt][7] = b1.w; } }
#pragma unroll
    for (int i = 0; i < 38; ++i) {
        const int tin = t0 - 30 + i;
        if (tin >= 0) {
            const v4u zr = *(const GAS v4u*)(Z + (bbase + tin) * 512 + 8 * lane);
            float zf[8]; zf[0] = bflo(zr.x); zf[1] = bfhi(zr.x); zf[2] = bflo(zr.y); zf[3] = bfhi(zr.y); zf[4] = bflo(zr.z); zf[5] = bfhi(zr.z); zf[6] = bflo(zr.w); zf[7] = bfhi(zr.w);
#pragma unroll
            for (int tt = 0; tt < 8; ++tt) { const int j = i - tt;
                if (j >= 0 && j <= 30) { const f32x4 w0 = *(const LAS f32x4*)(wl + j * 512 + 8 * lane), w1 = *(const LAS f32x4*)(wl + j * 512 + 8 * lane + 4);
                    acc[tt][0] += w0.x * zf[0]; acc[tt][1] += w0.y * zf[1]; acc[tt][2] += w0.z * zf[2]; acc[tt][3] += w0.w * zf[3];
                    acc[tt][4] += w1.x * zf[4]; acc[tt][5] += w1.y * zf[5]; acc[tt][6] += w1.z * zf[6]; acc[tt][7] += w1.w * zf[7]; } }
        }
    }
    const f32x4 g0 = *(const f32x4*)(ln_g + 8 * lane), g1 = *(const f32x4*)(ln_g + 8 * lane + 4), h0 = *(const f32x4*)(ln_b + 8 * lane), h1 = *(const f32x4*)(ln_b + 8 * lane + 4);
    const float gg[8] = {g0.x, g0.y, g0.z, g0.w, g1.x, g1.y, g1.z, g1.w}, hh[8] = {h0.x, h0.y, h0.z, h0.w, h1.x, h1.y, h1.z, h1.w};
#pragma unroll
    for (int tt = 0; tt < 8; ++tt) {
        float s = 0.f;
#pragma unroll
        for (int c = 0; c < 8; ++c) s += acc[tt][c];
        const float mean = wave_sum(s) * (1.f / CC); float q = 0.f;
#pragma unroll
        for (int c = 0; c < 8; ++c) { const float d = acc[tt][c] - mean; q += d * d; }
        const float rstd = 1.f / sqrtf(wave_sum(q) * (1.f / CC) + EPS);
        float y[8];
#pragma unroll
        for (int c = 0; c < 8; ++c) { const float u = (acc[tt][c] - mean) * rstd * gg[c] + hh[c]; y[c] = u * sigmf(u); }
        v4u o; o.x = pk2(y[0], y[1]); o.y = pk2(y[2], y[3]); o.z = pk2(y[4], y[5]); o.w = pk2(y[6], y[7]);
        *(GAS v4u*)(CO + (size_t)(m0 + tt) * 512 + 8 * lane) = o;
    }
}


#if defined(CHECKS)
__device__ __forceinline__ unsigned hash_u32(unsigned x) { x ^= x >> 16; x *= 0x7feb352du; x ^= x >> 15; x *= 0x846ca68bu; x ^= x >> 16; return x; }
__device__ __forceinline__ float bf2f(bf16 v) { return __builtin_bit_cast(float, (unsigned)v << 16); }
__device__ __forceinline__ float rbf(float v) { return __builtin_bit_cast(float, f2bf(v) << 16); }
__device__ __forceinline__ float wdot(const bf16* arow, const float* W, int K, int N, int col, int lane) {
    float s = 0.f; for (int k = lane; k < K; k += 64) s = __builtin_fmaf(bf2f(arow[k]), rbf(W[(size_t)k * N + col]), s); return wave_sum(s); }
__device__ __forceinline__ void chk_fail(gu32* ctl, bool bad) { if (bad) __hip_atomic_store(ctl + CW_CHK, 1u, RLX_AGENT); }
__device__ __forceinline__ bool far(float got, float exp, float rel, float abs_) { const float d = fabsf(got - exp); return !(d <= rel * fabsf(exp) + abs_); }
#define CHK_ON(id) ((CHECKS >> (id)) & 1)
#endif
#if defined(TWOLAUNCH)
#ifndef TWOLAUNCH_LO
#define TWOLAUNCH_LO 0
#define TWOLAUNCH_HI 0
#endif
#if defined(TWOLAUNCH_RECHECK)
#define TL_CMP 0
#else
#define TL_CMP 1
#endif
#define TL_CHECK(ph) do { if ((ph) == TWOLAUNCH_PH) { \
    GRID_BAR(); \
    const GAS unsigned* p_ = (TWOLAUNCH_WHAT == 0) ? (const GAS unsigned*)out : (const GAS unsigned*)(ws + (size_t)TWOLAUNCH_LO * MiB); \
    const size_t n_ = (TWOLAUNCH_WHAT == 0) ? (size_t)M * D : ((size_t)(TWOLAUNCH_HI - TWOLAUNCH_LO) * MiB) / 4; \
    unsigned acc_ = 0u; \
    for (size_t i_ = (size_t)blockIdx.x * 512 + F.tid; i_ < n_; i_ += (size_t)F.G * 512) acc_ += p_[i_] * (unsigned)(2654435761u + (unsigned)i_); \
    __hip_atomic_fetch_add(F.ctl + 8 + (int)args.flags, acc_, RLX_AGENT); \
    GRID_BAR(); \
    if (TL_CMP && args.flags == 1ull && F.tid == 0 && (__hip_atomic_load(F.ctl + 8, RLX_AGENT) != __hip_atomic_load(F.ctl + 9, RLX_AGENT))) __hip_atomic_store(F.ctl + CW_CHK, 1u, RLX_AGENT); \
  } } while (0)
#else
#define TL_CHECK(ph) do {} while (0)
#endif

struct Args { const float* in[17]; float* out; unsigned char* ws; int ph_lo, ph_hi; unsigned long long flags; };
constexpr int N_PHASES = 11;
__global__ void __launch_bounds__(NWAVES * 64, 2) mk_fwd(Args args) {
    extern __shared__ __attribute__((aligned(16))) unsigned char lds[];
    Frame F;
    F.lds = (LAS unsigned char*)lds;
    F.MISC = (volatile LAS unsigned*)(F.lds + MISC_OFF);
    F.tid = threadIdx.x; F.lane = F.tid & 63; F.wave = __builtin_amdgcn_readfirstlane(F.tid >> 6);
    F.G = gridDim.x; { const int bx = blockIdx.x; F.vcu = (F.G % 8 == 0) ? (bx % 8) * (F.G / 8) + bx / 8 : bx; }
    unsigned char* ws = args.ws;
    F.ctl = (gu32*)(ws + WS_CTL);
    const float* x = args.in[0]; const float* c_in = args.in[1]; const float* norm_mix_g = args.in[2]; const float* w_in = args.in[3]; const float* w_dw = args.in[4];
    const float* b_dw = args.in[5]; const float* conv_ln_g = args.in[6]; const float* conv_ln_b = args.in[7]; const float* w_attn_proj = args.in[8]; const float* w_conv_proj = args.in[9];
    const float* w_out = args.in[10]; const float* norm_ffn_g = args.in[11]; const float* w_ffn_in = args.in[12]; const float* w_ffn_out = args.in[13]; const float* w_ada = args.in[14];
    const float* b_ada = args.in[15]; const float* norm_final_g = args.in[16];
    float* out = args.out;
    bf16* Win_t = (bf16*)(ws + WS_WIN); bf16* Wap_t = (bf16*)(ws + WS_WAP); bf16* Wcp_t = (bf16*)(ws + WS_WCP); bf16* Wout_t = (bf16*)(ws + WS_WOUT);
    bf16* Wff1_t = (bf16*)(ws + WS_WFF1); bf16* Wff2_t = (bf16*)(ws + WS_WFF2);
    float* MOD = (float*)(ws + WS_MOD); float* MODP = (float*)(ws + WS_MODP);
    bf16* KIb = (bf16*)(ws + WS_KI); float* WIb = (float*)(ws + WS_WI); bf16* XN = (bf16*)(ws + WS_XN);
    bf16* Qb = (bf16*)(ws + WS_Q); bf16* Kb = (bf16*)(ws + WS_K); bf16* Vb = (bf16*)(ws + WS_V); bf16* QIb = (bf16*)(ws + WS_QI); bf16* Zb = (bf16*)(ws + WS_Z);
    bf16* SGA = (bf16*)(ws + WS_SGA); bf16* SGB = (bf16*)(ws + WS_SGB); unsigned* MASKb = (unsigned*)(ws + WS_MASK); bf16* COb = (bf16*)(ws + WS_CO);
    bf16* T1b = (bf16*)(ws + WS_V);
    bf16* MERGED = (bf16*)(ws + WS_MERGED); bf16* XN2 = (bf16*)(ws + WS_XN2); bf16* Hb = (bf16*)(ws + WS_H);

    for (int u = F.tid; u < (LDS_BYTES - LDSCTL_OFF) / 4; u += NWAVES * 64) ((LAS unsigned*)(F.lds + LDSCTL_OFF))[u] = 0u;
    __syncthreads();
    XcdBarrier bar = xcd_barrier_post((unsigned*)(F.ctl + CW_BAR), F.MISC + 8);
    const int lo = args.ph_lo, hi = args.ph_hi;
#define IN(k) (lo <= (k) && (k) < hi)
#define BOTH(k) (IN(k) && IN((k) + 1))
#define GRID_BAR() xcd_barrier(bar)
    const int gw = F.vcu * NWAVES + F.wave, NGW = F.G * NWAVES;
#if defined(TWOLAUNCH) && defined(TWOLAUNCH_RECHECK)
    if (args.flags == 1ull) {
        const GAS unsigned* p_ = (const GAS unsigned*)(ws + (size_t)TWOLAUNCH_LO * MiB); const size_t n_ = ((size_t)(TWOLAUNCH_HI - TWOLAUNCH_LO) * MiB) / 4; unsigned acc_ = 0u;
        for (size_t i_ = (size_t)blockIdx.x * 512 + F.tid; i_ < n_; i_ += (size_t)F.G * 512) acc_ += p_[i_] * (unsigned)(2654435761u + (unsigned)i_);
        __hip_atomic_fetch_add(F.ctl + 10, acc_, RLX_AGENT);
        GRID_BAR();
        if (F.tid == 0 && (__hip_atomic_load(F.ctl + 8, RLX_AGENT) != __hip_atomic_load(F.ctl + 10, RLX_AGENT))) __hip_atomic_store(F.ctl + CW_CHK, 1u, RLX_AGENT);
    }
#endif

#if defined(PREFILL)
    {
        const size_t lo_b = (size_t)PREFILL_LO * MiB, hi_b = (size_t)PREFILL_HI * MiB; const size_t n16 = (hi_b - lo_b) / 16;
        GAS v4u* p = (GAS v4u*)(ws + lo_b);
        for (size_t i = (size_t)blockIdx.x * 512 + F.tid; i < n16; i += (size_t)F.G * 512) p[i] = (v4u){0x3c003c00u, 0x3c003c00u, 0x3c003c00u, 0x3c003c00u};
        GRID_BAR();
    }
#endif
#if defined(L2TEST)
    {
        GAS unsigned* R = (GAS unsigned*)(ws + (size_t)246 * MiB);
        const int w = blockIdx.x;
        for (int i = F.tid; i < 1024; i += 512) R[w * 1024 + i] = 0xA0000000u + (unsigned)(w * 1024 + i);
        GRID_BAR();
        { unsigned bad = 0u; for (int i = F.tid; i < 256 * 1024; i += 512) bad |= (R[i] != 0xA0000000u + (unsigned)i); if (bad) __hip_atomic_store(F.ctl + CW_CHK, 1u, RLX_AGENT); }
        GRID_BAR();
        { const int w2 = (w + L2TEST) & 255; for (int i = F.tid; i < 1024; i += 512) R[w2 * 1024 + i] = 0xB0000000u + (unsigned)(w2 * 1024 + i); }
        GRID_BAR();
        { unsigned bad = 0u; for (int i = F.tid; i < 256 * 1024; i += 512) bad |= (R[i] != 0xB0000000u + (unsigned)i); if (bad) __hip_atomic_store(F.ctl + CW_CHK, 1u, RLX_AGENT); }
        GRID_BAR();
    }
#endif
    if (IN(0)) {
        for (int it = gw; it < 16 * 96; it += NGW) {
            const int kc = it / 96, cc = it % 96, n = cc * 64 + F.lane, k0 = kc * 64; float a0 = 0.f, a1 = 0.f;
#pragma unroll 8
            for (int kk = 0; kk < 64; ++kk) { const float w = w_ada[(size_t)(k0 + kk) * (NMOD * D) + n]; const float c0 = c_in[k0 + kk], c1 = c_in[D + k0 + kk];
                a0 = __builtin_fmaf(c0 * sigmf(c0), w, a0); a1 = __builtin_fmaf(c1 * sigmf(c1), w, a1); }
            MODP[(size_t)(kc * 2 + 0) * (NMOD * D) + n] = a0; MODP[(size_t)(kc * 2 + 1) * (NMOD * D) + n] = a1;
        }
        LAS float* scr = (LAS float*)(F.lds + RING_OFF + F.wave * 16384);
        constexpr int I_IN = (D / 64) * (NIN_PAD / 32), I_AP = (AW / 64) * (D / 32), I_CP = I_AP, I_OUT = (D / 64) * (D / 32), I_F1 = (D / 64) * (NFF1 / 32), I_F2 = (DFF / 64) * (D / 32);
        constexpr int NITEMS = I_IN + I_AP + I_CP + I_OUT + I_F1 + I_F2;
        for (int it = gw; it < NITEMS; it += NGW) {
            int r = it; int sc0, nv;
            if (r < I_IN) { const int nblk = NIN_PAD / 32, kb = r / nblk, nb = r % nblk; win_map(32 * nb, sc0, nv); p0_transpose_item(w_in, D, NIN, Win_t, kb, 32 * nb, sc0, nv, scr, F.lane); continue; } r -= I_IN;
            if (r < I_AP) { const int nblk = D / 32, kb = r / nblk, nb = r % nblk; p0_transpose_item(w_attn_proj, AW, D, Wap_t, kb, 32 * nb, 32 * nb, 32, scr, F.lane); continue; } r -= I_AP;
            if (r < I_CP) { const int nblk = D / 32, kb = r / nblk, nb = r % nblk; p0_transpose_item(w_conv_proj, CC, D, Wcp_t, kb, 32 * nb, 32 * nb, 32, scr, F.lane); continue; } r -= I_CP;
            if (r < I_OUT) { const int nblk = D / 32, kb = r / nblk, nb = r % nblk; p0_transpose_item(w_out, D, D, Wout_t, kb, 32 * nb, 32 * nb, 32, scr, F.lane); continue; } r -= I_OUT;
            if (r < I_F1) { const int nblk = NFF1 / 32, kb = r / nblk, nb = r % nblk; ff1_map(32 * nb, sc0, nv); p0_transpose_item(w_ffn_in, D, NFF1, Wff1_t, kb, 32 * nb, sc0, nv, scr, F.lane); continue; } r -= I_F1;
            { const int nblk = D / 32, kb = r / nblk, nb = r % nblk; p0_transpose_item(w_ffn_out, DFF, D, Wff2_t, kb, 32 * nb, 32 * nb, 32, scr, F.lane); }
        }
        TL_CHECK(0); if (BOTH(0)) GRID_BAR();
    }
    if (IN(1)) {
#if defined(CHECK_W)
        {
            const size_t lo_b = (size_t)1 * MiB, hi_b = (size_t)34 * MiB; const size_t n16 = (hi_b - lo_b) / 16; const GAS v4u* p = (const GAS v4u*)(ws + lo_b); unsigned bad = 0u;
            for (size_t i = (size_t)blockIdx.x * 512 + F.tid; i < n16; i += (size_t)F.G * 512) { const v4u w = p[i]; bad += (w.x == 0x3c003c00u) + (w.y == 0x3c003c00u) + (w.z == 0x3c003c00u) + (w.w == 0x3c003c00u); }
            if (bad) __hip_atomic_fetch_add(F.ctl + 3, bad, RLX_AGENT);
        }
#endif
#if defined(PREFILL1)
        {
            const size_t lo_b = (size_t)38 * MiB, hi_b = (size_t)70 * MiB; const size_t n16 = (hi_b - lo_b) / 16;
            GAS v4u* p = (GAS v4u*)(ws + lo_b);
            for (size_t i = (size_t)blockIdx.x * 512 + F.tid; i < n16; i += (size_t)F.G * 512) p[i] = (v4u){0x3c003c00u, 0x3c003c00u, 0x3c003c00u, 0x3c003c00u};
            GRID_BAR();
        }
#endif
        LAS float* A = (LAS float*)(F.lds + RING_OFF); LAS float* Bv = A + D;
        const int b = F.vcu >> 7;
        for (int c = F.tid; c < D; c += NWAVES * 64) { float sh = b_ada[c], sc = b_ada[D + c];
#pragma unroll
            for (int kc = 0; kc < 16; ++kc) { sh += MODP[(size_t)(kc * 2 + b) * (NMOD * D) + c]; sc += MODP[(size_t)(kc * 2 + b) * (NMOD * D) + D + c]; }
            A[c] = norm_mix_g[c] * (1.f + sc); Bv[c] = sh; }
        if (F.vcu < 24) { const int o = F.vcu * 512 + F.tid, bb = o / (NMOD * D), n = o % (NMOD * D); float s = b_ada[n];
#pragma unroll
            for (int kc = 0; kc < 16; ++kc) s += MODP[(size_t)(kc * 2 + bb) * (NMOD * D) + n];
            MOD[(size_t)bb * (NMOD * D) + n] = s; }
        LDS_WAIT(); __syncthreads();
        for (int i = 0; i < 8; ++i) { const int m = F.vcu * 64 + F.wave * 8 + i; rms_row_to_bf16(x + (size_t)m * D, XN + (size_t)m * D, A, Bv, F.lane); }
        TL_CHECK(1); if (BOTH(1)) GRID_BAR();
    }
    if (IN(2)) {
#if defined(CHECK_WIN)
        {
            unsigned bad = 0u;
            for (int i = 0; i < 256; ++i) { const unsigned h = hash_u32((unsigned)((blockIdx.x * 512 + F.tid) * 256 + i + 99)); const int dr = 3072 + (int)(h % 2048u), k = (int)((h >> 11) % 1024u);
                bad |= ((unsigned)Win_t[(size_t)dr * D + k] != f2bf(w_in[(size_t)k * NIN + (dr < 4096 ? 3144 + (dr - 3072) : 4168 + (dr - 4096))])); }
            if (bad) __hip_atomic_store(F.ctl + CW_CHK, 1u, RLX_AGENT);
        }
#endif
#if defined(PREFILL) && defined(CHECK_XN)
        {
            const int sl = (F.vcu + CHECK_XN) & 255; const GAS v4u* p = (const GAS v4u*)(ws + WS_XN) + (size_t)sl * 8192; unsigned bad = 0u;
            for (int i = F.tid; i < 8192; i += NWAVES * 64) { const v4u w = p[i]; bad |= (w.x == 0x3c003c00u) | (w.y == 0x3c003c00u) | (w.z == 0x3c003c00u) | (w.w == 0x3c003c00u); }
            if (bad) __hip_atomic_store(F.ctl + CW_CHK, 1u, RLX_AGENT);
        }
#endif
        pg8::Gemm g{XN, Win_t, M, NIN_PAD, D}; pg8::StaticOrder S; S.init(M, NIN_PAD, F.G, (int)blockIdx.x);
        pg8::EpiInProj E{Qb, Kb, Vb, QIb, Zb, SGA, SGB, KIb, WIb};
        pg8::gemm_phase<pg8::EpiInProj, pg8::StaticOrder, P2_ALIGN, P2_SP2>(F.lds + RING_OFF, g, S, E);
        TL_CHECK(2); if (BOTH(2)) GRID_BAR();
    }
    if (IN(3)) {
#if defined(CHECKS)
        if (CHK_ON(19)) for (int i = 0; i < 32; ++i) { const unsigned h = hash_u32((unsigned)(gw * 277 + i + 4242)); const int m = CHK19_ROW0 + (int)(h % (unsigned)CHK19_NROW), c2 = CHK19_COL0 + (int)((h >> 14) % (unsigned)CHK19_NCOL); const bf16* xr = XN + (size_t)m * D; bool bad = false;
            if (!CHK_ON(18)) bad |= far(bf2f(SGA[(size_t)m * 1024 + c2]), sigmf(wdot(xr, w_in, D, NIN, 3144 + c2, F.lane)), CHK19_REL, CHK19_ABS);
            if (!CHK_ON(17)) bad |= far(bf2f(SGB[(size_t)m * 1024 + c2]), sigmf(wdot(xr, w_in, D, NIN, 4168 + c2, F.lane)), CHK19_REL, CHK19_ABS);
            if (bad && F.lane == 0) __hip_atomic_fetch_add(F.ctl + 3, 1u, RLX_AGENT); }
#endif

#if defined(CHECKS)
        for (int i = 0; i < 6; ++i) { const unsigned h = hash_u32((unsigned)(gw * 131 + i)); const int m = (int)(h % (unsigned)M); const int bb = m >> 13; bool bad = false;
            if (CHK_ON(1)) { const int n = (int)((h >> 8) % (unsigned)(NMOD * D)); float sacc = 0.f; for (int k = F.lane; k < D; k += 64) { const float cv = c_in[bb * D + k]; sacc = __builtin_fmaf(cv * sigmf(cv), w_ada[(size_t)k * (NMOD * D) + n], sacc); }
                const float e = wave_sum(sacc) + b_ada[n]; bad |= far(MOD[(size_t)bb * (NMOD * D) + n], e, 2e-3f, 2e-4f); }
            if (CHK_ON(2)) { const int c = (int)((h >> 10) % (unsigned)D); float s2 = 0.f; for (int k = F.lane; k < D; k += 64) { const float v = x[(size_t)m * D + k]; s2 = __builtin_fmaf(v, v, s2); }
                const float rstd = 1.f / sqrtf(wave_sum(s2) * (1.f / D) + EPS); const float e = x[(size_t)m * D + c] * rstd * norm_mix_g[c] * (1.f + MOD[(size_t)bb * (NMOD * D) + D + c]) + MOD[(size_t)bb * (NMOD * D) + c];
                bad |= far(bf2f(XN[(size_t)m * D + c]), e, 1e-2f, 1e-2f); }
            if (CHK_ON(3)) { const int c = (int)((h >> 12) % 512u); const bf16* xr = XN + (size_t)m * D;
                bad |= far(bf2f(Qb[(size_t)m * 512 + c]), pg8::QSCALE * wdot(xr, w_in, D, NIN, c, F.lane), 2e-2f, 2e-2f);
                bad |= far(bf2f(Kb[(size_t)m * 512 + c]), wdot(xr, w_in, D, NIN, 512 + c, F.lane), 2e-2f, 2e-2f);
                bad |= far(bf2f(Vb[(size_t)m * 512 + c]), wdot(xr, w_in, D, NIN, 1024 + c, F.lane), 2e-2f, 2e-2f);
                bad |= far(bf2f(QIb[(size_t)m * 512 + c]), wdot(xr, w_in, D, NIN, 1536 + c, F.lane), 2e-2f, 2e-2f);
                bad |= far(bf2f(KIb[(size_t)m * 64 + (c & 63)]), wdot(xr, w_in, D, NIN, 2048 + (c & 63), F.lane), 2e-2f, 2e-2f);
                bad |= far(WIb[(size_t)m * 8 + (c & 7)], wdot(xr, w_in, D, NIN, 2112 + (c & 7), F.lane), 2e-2f, 2e-2f);
                { const float a = wdot(xr, w_in, D, NIN, 2120 + c, F.lane), g = wdot(xr, w_in, D, NIN, 2632 + c, F.lane); bad |= far(bf2f(Zb[(size_t)m * 512 + c]), a * sigmf(g), 2e-2f, 2e-2f); }
                { const int c2 = (int)((h >> 5) % 1024u); bad |= far(bf2f(SGA[(size_t)m * 1024 + c2]), sigmf(wdot(xr, w_in, D, NIN, 3144 + c2, F.lane)), 2e-2f, 1e-2f);
                  bad |= far(bf2f(SGB[(size_t)m * 1024 + c2]), sigmf(wdot(xr, w_in, D, NIN, 4168 + c2, F.lane)), 2e-2f, 1e-2f); } }
            if (CHK_ON(14) && (int)args.flags == CHECK14_LAUNCH) { const bf16* xr2 = XN + (size_t)m * D;
                for (int q = 0; q < 8; ++q) { const unsigned h2 = hash_u32(h + 977u * (unsigned)q + 13u); const int m2 = CHK14_ROW0 + (int)(h2 % 2048u), c2 = (int)((h2 >> 11) % 1024u);
                    if (far(bf2f(CHK14_BUF[(size_t)m2 * 1024 + c2]), sigmf(wdot(XN + (size_t)m2 * D, w_in, D, NIN, CHK14_COL + c2, F.lane)), 1e-2f, 4e-3f) && F.lane == 0) __hip_atomic_fetch_add(F.ctl + 3, 1u, RLX_AGENT); } (void)xr2; }
            chk_fail(F.ctl, bad); }
#endif
#if defined(PREFILL3)
        {
            const size_t lo_b = (size_t)38 * MiB, hi_b = (size_t)70 * MiB; const size_t n16 = (hi_b - lo_b) / 16;
            GAS v4u* p = (GAS v4u*)(ws + lo_b);
            for (size_t i = (size_t)blockIdx.x * 512 + F.tid; i < n16; i += (size_t)F.G * 512) p[i] = (v4u){0x3c003c00u, 0x3c003c00u, 0x3c003c00u, 0x3c003c00u};
        }
#endif
#if !defined(SKIP_IDX)
        { const int b = F.vcu >> 7, s = F.vcu & 127;
          idx_body::idx_unit(b, s, QIb, KIb, WIb, MASKb, (char*)lds + RING_OFF, (unsigned*)(F.ctl + CW_CHK));
          idx_body::idx_unit(b, 255 - s, QIb, KIb, WIb, MASKb, (char*)lds + RING_OFF, (unsigned*)(F.ctl + CW_CHK)); }
#endif
        { LAS float* wl = (LAS float*)(F.lds + RING_OFF);
          for (int i = F.tid; i < CWID * CC / 4; i += NWAVES * 64) ((LAS f32x4*)wl)[i] = ((const f32x4*)w_dw)[i];
          LDS_WAIT(); __syncthreads();
#if defined(SKIP_CONV)
          for (int tt = 0; tt < 8; ++tt) *(GAS v4u*)(COb + (size_t)(8 * gw + tt) * 512 + 8 * F.lane) = (v4u){0u, 0u, 0u, 0u};
#else
          conv_item(8 * gw, Zb, wl, b_dw, conv_ln_g, conv_ln_b, COb, F.lane);
#endif
          __syncthreads(); }
        TL_CHECK(3); if (BOTH(3)) GRID_BAR();
    }
    if (IN(4)) {
#if defined(CHECKS)
        if (CHK_ON(16)) for (int i = 0; i < 8; ++i) { const unsigned h = hash_u32((unsigned)(gw * 277 + i + 4242)); const int m = (int)(h % (unsigned)M), c2 = (int)((h >> 14) % 1024u); const bf16* xr = XN + (size_t)m * D; bool bad = false;
            if (!CHK_ON(18)) bad |= far(bf2f(SGA[(size_t)m * 1024 + c2]), sigmf(wdot(xr, w_in, D, NIN, 3144 + c2, F.lane)), 2e-2f, 1e-2f);
            if (!CHK_ON(17)) bad |= far(bf2f(SGB[(size_t)m * 1024 + c2]), sigmf(wdot(xr, w_in, D, NIN, 4168 + c2, F.lane)), 2e-2f, 1e-2f);
            chk_fail(F.ctl, bad); }
#endif
#if defined(LDS_FILL)
        { for (int i = F.tid; i < RING_BYTES / 4; i += NWAVES * 64) ((LAS unsigned*)(F.lds + RING_OFF))[i] = (unsigned)LDS_FILL; LDS_WAIT(); __syncthreads(); }
#endif
#if defined(SKIP_ATT)
        for (int i = 0; i < 64; ++i) { const int m = F.vcu * 64 + i; ((GAS unsigned short*)Qb)[(size_t)m * 512 + F.tid] = 0; }
#else
#if defined(ATT_TWICE)
        { GAS v4u* Qv = (GAS v4u*)Qb; GAS v4u* S1 = (GAS v4u*)(ws + (size_t)38 * MiB); const size_t n16 = (size_t)M * 512 * 2 / 16;
          for (size_t i = (size_t)blockIdx.x * 512 + F.tid; i < n16; i += (size_t)F.G * 512) S1[i] = Qv[i];
          GRID_BAR(); }
#endif
        const attn_body::AttnTensors AT{(const attn_body::bf16*)Qb, (const attn_body::bf16*)Kb, (const attn_body::bf16*)Vb, (attn_body::bf16*)Qb, (const unsigned long long*)MASKb};
        const attn_body::StaticOrder S((int)F.G, (int)blockIdx.x);
        attn_body::attn_phase<attn_body::StaticOrder, ATT_THRL>((char*)lds + RING_OFF, AT, S);
#endif
#if defined(ATT_TWICE)
        {
            GAS v4u* Qv = (GAS v4u*)Qb; GAS v4u* S1 = (GAS v4u*)(ws + (size_t)38 * MiB); GAS v4u* S2 = (GAS v4u*)(ws + (size_t)54 * MiB); const size_t n16 = (size_t)M * 512 * 2 / 16;
            GRID_BAR();
            for (size_t i = (size_t)blockIdx.x * 512 + F.tid; i < n16; i += (size_t)F.G * 512) { S2[i] = Qv[i]; Qv[i] = S1[i]; }
            GRID_BAR();
            { const attn_body::AttnTensors AT2{(const attn_body::bf16*)Qb, (const attn_body::bf16*)Kb, (const attn_body::bf16*)Vb, (attn_body::bf16*)Qb, (const unsigned long long*)MASKb};
              const attn_body::StaticOrder S2o((int)F.G, (int)blockIdx.x);
              attn_body::attn_phase<attn_body::StaticOrder, ATT_THRL>((char*)lds + RING_OFF, AT2, S2o); }
            GRID_BAR();
            { unsigned bad = 0u; for (size_t i = (size_t)blockIdx.x * 512 + F.tid; i < n16; i += (size_t)F.G * 512) { const v4u a = S2[i], b = Qv[i]; bad |= (a.x != b.x) | (a.y != b.y) | (a.z != b.z) | (a.w != b.w); }
              if (bad) __hip_atomic_store(F.ctl + CW_CHK, 1u, RLX_AGENT); }
        }
#endif
        TL_CHECK(4); if (BOTH(4)) GRID_BAR();
    }
#if defined(DUMP_P4)
    {
        for (int i = 0; i < 64; ++i) { const int m = F.vcu * 64 + i; const int c = F.tid * 2;
            const bf16* src = (c < 512) ? (Qb + (size_t)m * 512 + c) : (COb + (size_t)m * 512 + (c - 512));
            const unsigned w = *(const unsigned*)src; out[(size_t)m * D + c] = bflo(w); out[(size_t)m * D + c + 1] = bfhi(w); }
        return;
    }
#endif
    if (IN(5)) {

#if defined(CHECKS)
        if (CHK_ON(11)) { const unsigned h = hash_u32((unsigned)(gw * 7 + 12345)); const int bb = (int)(h & 1u); int t = (int)((h >> 1) % (unsigned)T); if ((gw & 7) == 0) t = (int)((h >> 1) % 600u);
            const bf16* qi = QIb + (size_t)(bb * T + t) * 512; const float* wi = WIb + (size_t)(bb * T + t) * 8;
            const unsigned long long* mrow_ = (const unsigned long long*)MASKb + ((size_t)(bb * (T / 32) + (t >> 5)) * (T / 64)) * 32 + (t & 31);
            int nsel = 0; float mn = INFINITY, mx = -INFINITY;
            for (int s0 = 0; s0 <= t; s0 += 64) { const int sidx = s0 + F.lane; const bool act = sidx <= t; float sc = 0.f;
                if (act) { const bf16* kr = KIb + (size_t)(bb * T + sidx) * 64;
                    for (int j = 0; j < 8; ++j) { float d = 0.f; for (int k = 0; k < 64; ++k) d = __builtin_fmaf(bf2f(qi[j * 64 + k]), bf2f(kr[k]), d); sc = __builtin_fmaf(wi[j], fmaxf(d, 0.f), sc); } }
                const unsigned long long mw = mrow_[(size_t)(s0 >> 6) * 32]; const bool selb = (mw >> F.lane) & 1ull;
                if (act) { if (selb) { ++nsel; mn = fminf(mn, sc); } else mx = fmaxf(mx, sc); } else if (selb) nsel += 100000; }
            for (int o = 1; o < 64; o <<= 1) { nsel += __shfl_xor(nsel, o); mn = fminf(mn, __shfl_xor(mn, o)); mx = fmaxf(mx, __shfl_xor(mx, o)); }
            const int want = (t + 1 < 256) ? t + 1 : 256;
            bool bad = (nsel != want); if (CHK_ON(13) && t + 1 > 256) bad |= !(mn >= mx - (1e-2f * fabsf(mx) + 1e-2f));
            for (int tt = (t >> 6) + 1 + F.lane; tt < T / 64; tt += 64) bad |= (mrow_[(size_t)tt * 32] != 0ull);
            chk_fail(F.ctl, __any(bad)); }
        if (CHK_ON(12)) { const unsigned h = hash_u32((unsigned)(gw * 13 + 777)); const int bb = (int)(h & 1u), hd = (int)((h >> 1) & 7u); int t = (int)((h >> 4) % (unsigned)T); if ((gw & 7) == 0) t = (int)((h >> 4) % 600u);
            const size_t row = (size_t)(bb * T + t);
            const float qd = rbf(pg8::QSCALE * ({ float sacc = 0.f; for (int k = 0; k < D; ++k) sacc = __builtin_fmaf(bf2f(XN[row * D + k]), rbf(w_in[(size_t)k * NIN + hd * 64 + F.lane]), sacc); sacc; }));
            const unsigned long long* mrow_ = (const unsigned long long*)MASKb + ((size_t)(bb * (T / 32) + (t >> 5)) * (T / 64)) * 32 + (t & 31);
#if defined(ATT_NOALIBI)
            const float slope2 = 0.f;
#else
            const float slope2 = exp2f(-(float)(hd + 1)) * 1.4426950408889634f;
#endif
            float mrun = -INFINITY, l = 0.f, o = 0.f;
            for (int tt = 0; tt <= (t >> 6); ++tt) {
#if defined(ATT_DENSE)
                const int dd_ = t - 64 * tt; const unsigned long long mw = (dd_ >= 63) ? ~0ull : ((2ull << dd_) - 1ull);
#else
                const unsigned long long mw = mrow_[(size_t)tt * 32];
#endif
                for (int kk = 0; kk < 64; ++kk) if ((mw >> kk) & 1ull) { const int sidx = tt * 64 + kk; const size_t kr = (size_t)(bb * T + sidx);
                    const float lg = wave_sum(qd * bf2f(Kb[kr * 512 + hd * 64 + F.lane])) + slope2 * (float)(sidx - t);
                    const float mnew = fmaxf(mrun, lg); const float f = exp2f(mrun - mnew), p = exp2f(lg - mnew); l = l * f + p; o = o * f + p * bf2f(Vb[kr * 512 + hd * 64 + F.lane]); mrun = mnew; } }
            const float e = o / l; chk_fail(F.ctl, __any(far(bf2f(Qb[row * 512 + hd * 64 + F.lane]), e, 3e-2f, 2e-2f))); }
        if (CHK_ON(15)) for (int i = 0; i < 8; ++i) { const unsigned h = hash_u32((unsigned)(gw * 271 + i + 4242)); const int m = (int)(h % (unsigned)M), c2 = (int)((h >> 14) % 1024u); const bf16* xr = XN + (size_t)m * D; bool bad = false;
            if (!CHK_ON(18)) bad |= far(bf2f(SGA[(size_t)m * 1024 + c2]), sigmf(wdot(xr, w_in, D, NIN, 3144 + c2, F.lane)), 2e-2f, 1e-2f);
            if (!CHK_ON(17)) bad |= far(bf2f(SGB[(size_t)m * 1024 + c2]), sigmf(wdot(xr, w_in, D, NIN, 4168 + c2, F.lane)), 2e-2f, 1e-2f);
            chk_fail(F.ctl, bad); }
        if (CHECKS & 0xb800) GRID_BAR();
#endif
        { pg8::Gemm g{Qb, Wap_t, M, D, AW}; pg8::StaticOrder S; S.init(M, D, F.G, (int)blockIdx.x);
          pg8::EpiGate<0> E{SGA, T1b, nullptr};
          pg8::gemm_phase<pg8::EpiGate<0>, pg8::StaticOrder, true, true>(F.lds + RING_OFF, g, S, E); }
        VM_WAIT(); __syncthreads();
        { pg8::Gemm g{COb, Wcp_t, M, D, CC}; pg8::StaticOrder S; S.init(M, D, F.G, (int)blockIdx.x);
          pg8::EpiGate<1> E{SGB, MERGED, T1b};
          pg8::gemm_phase<pg8::EpiGate<1>, pg8::StaticOrder, true, true>(F.lds + RING_OFF, g, S, E); }
        TL_CHECK(5); if (BOTH(5)) GRID_BAR();
    }
    if (IN(6)) {

#if defined(CHECKS)
        for (int i = 0; i < 4; ++i) { const unsigned h = hash_u32((unsigned)(gw * 977 + i + 77)); const int m = (int)(h % (unsigned)M); bool bad = false;
            if (CHK_ON(4)) { const int t0 = m & (T - 1); float v[8]; const f32x4 b0 = *(const f32x4*)(b_dw + 8 * F.lane), b1 = *(const f32x4*)(b_dw + 8 * F.lane + 4);
                v[0] = b0.x; v[1] = b0.y; v[2] = b0.z; v[3] = b0.w; v[4] = b1.x; v[5] = b1.y; v[6] = b1.z; v[7] = b1.w;
                for (int j = 0; j < CWID; ++j) { const int tin = t0 - 30 + j; if (tin >= 0) { for (int c = 0; c < 8; ++c) v[c] = __builtin_fmaf(w_dw[j * CC + 8 * F.lane + c], bf2f(Zb[(size_t)(m - t0 + tin) * 512 + 8 * F.lane + c]), v[c]); } }
                float sacc = 0.f; for (int c = 0; c < 8; ++c) sacc += v[c]; const float mean = wave_sum(sacc) * (1.f / CC); float q = 0.f; for (int c = 0; c < 8; ++c) q += (v[c] - mean) * (v[c] - mean);
                const float rstd = 1.f / sqrtf(wave_sum(q) * (1.f / CC) + EPS);
                for (int c = 0; c < 8; ++c) { const float u = (v[c] - mean) * rstd * conv_ln_g[8 * F.lane + c] + conv_ln_b[8 * F.lane + c]; bad |= far(bf2f(COb[(size_t)m * 512 + 8 * F.lane + c]), u * sigmf(u), 3e-2f, 3e-2f); } }
            if (CHK_ON(5)) { const int c = (int)((h >> 9) % 1024u);
                const float e = bf2f(SGA[(size_t)m * 1024 + c]) * wdot(Qb + (size_t)m * 512, w_attn_proj, AW, D, c, F.lane) + bf2f(SGB[(size_t)m * 1024 + c]) * wdot(COb + (size_t)m * 512, w_conv_proj, CC, D, c, F.lane);
                bad |= far(bf2f(MERGED[(size_t)m * 1024 + c]), e, 3e-2f, 3e-2f); }
            chk_fail(F.ctl, bad); }
#endif
        pg8::Gemm g{MERGED, Wout_t, M, D, D}; pg8::StaticOrder S; S.init(M, D, F.G, (int)blockIdx.x);
        pg8::EpiResid E{x, out, MOD + 2 * D, NMOD * D};
        pg8::gemm_phase<pg8::EpiResid, pg8::StaticOrder, true, true>(F.lds + RING_OFF, g, S, E);
        TL_CHECK(6); if (BOTH(6)) GRID_BAR();
    }
    if (IN(7)) {

#if defined(CHECKS)
        if (CHK_ON(6)) for (int i = 0; i < 4; ++i) { const unsigned h = hash_u32((unsigned)(gw * 613 + i + 991)); const int m = (int)(h % (unsigned)M), c = (int)((h >> 14) % 1024u), bb = m >> 13;
            const float e = x[(size_t)m * D + c] + MOD[(size_t)bb * (NMOD * D) + 2 * D + c] * wdot(MERGED + (size_t)m * 1024, w_out, D, D, c, F.lane);
            chk_fail(F.ctl, far(out[(size_t)m * D + c], e, 1e-2f, 1e-2f)); }
#endif
        LAS float* A = (LAS float*)(F.lds + RING_OFF); LAS float* Bv = A + D;
        const int b = F.vcu >> 7;
        for (int c = F.tid; c < D; c += NWAVES * 64) { A[c] = norm_ffn_g[c] * (1.f + MOD[(size_t)b * (NMOD * D) + 4 * D + c]); Bv[c] = MOD[(size_t)b * (NMOD * D) + 3 * D + c]; }
        LDS_WAIT(); __syncthreads();
        for (int i = 0; i < 8; ++i) { const int m = F.vcu * 64 + F.wave * 8 + i; rms_row_to_bf16(out + (size_t)m * D, XN2 + (size_t)m * D, A, Bv, F.lane); }
        TL_CHECK(7); if (BOTH(7)) GRID_BAR();
    }
    if (IN(8)) {

#if defined(CHECKS)
        if (CHK_ON(8)) for (int i = 0; i < 4; ++i) { const unsigned h = hash_u32((unsigned)(gw * 419 + i + 5)); const int m = (int)(h % (unsigned)M), c = (int)((h >> 14) % 1024u), bb = m >> 13;
            float s2 = 0.f; for (int k = F.lane; k < D; k += 64) { const float v = out[(size_t)m * D + k]; s2 = __builtin_fmaf(v, v, s2); }
            const float rstd = 1.f / sqrtf(wave_sum(s2) * (1.f / D) + EPS); const float e = out[(size_t)m * D + c] * rstd * norm_ffn_g[c] * (1.f + MOD[(size_t)bb * (NMOD * D) + 4 * D + c]) + MOD[(size_t)bb * (NMOD * D) + 3 * D + c];
            chk_fail(F.ctl, far(bf2f(XN2[(size_t)m * D + c]), e, 1e-2f, 1e-2f)); }
#endif
        pg8::Gemm g{XN2, Wff1_t, M, NFF1, D}; pg8::StaticOrder S; S.init(M, NFF1, F.G, (int)blockIdx.x);
        pg8::EpiSwiGLU E{Hb, DFF};
        pg8::gemm_phase<pg8::EpiSwiGLU, pg8::StaticOrder, true, true>(F.lds + RING_OFF, g, S, E);
        TL_CHECK(8); if (BOTH(8)) GRID_BAR();
    }
    if (IN(9)) {

#if defined(CHECKS)
        if (CHK_ON(7)) for (int i = 0; i < 4; ++i) { const unsigned h = hash_u32((unsigned)(gw * 211 + i + 3)); const int m = (int)(h % (unsigned)M), j = (int)((h >> 13) % (unsigned)DFF);
            const float a = wdot(XN2 + (size_t)m * D, w_ffn_in, D, NFF1, j, F.lane), bq = wdot(XN2 + (size_t)m * D, w_ffn_in, D, NFF1, DFF + j, F.lane);
            chk_fail(F.ctl, far(bf2f(Hb[(size_t)m * DFF + j]), a * sigmf(a) * bq, 3e-2f, 3e-2f)); }
#endif
        pg8::Gemm g{Hb, Wff2_t, M, D, DFF}; pg8::StaticOrder S; S.init(M, D, F.G, (int)blockIdx.x);
        pg8::EpiResid E{out, out, MOD + 5 * D, NMOD * D};
#if defined(P9_VARIANT)
        pg8::gemm_phase<pg8::EpiResid, pg8::StaticOrder, false, false>(F.lds + RING_OFF, g, S, E);
#else
        pg8::gemm_phase<pg8::EpiResid, pg8::StaticOrder, true, true>(F.lds + RING_OFF, g, S, E);
#endif
        TL_CHECK(9); if (BOTH(9)) GRID_BAR();
    }
    if (IN(10)) {

#if defined(CHECKS)
        if (CHK_ON(10)) for (int i = 0; i < 64; ++i) { const unsigned h = hash_u32((unsigned)((gw * 64 + F.lane) * 64 + i + 17)); const int n = (int)(h % 1024u), k = (int)((h >> 10) % (unsigned)DFF);
            const bool bad = (unsigned)Wff2_t[(size_t)n * DFF + k] != f2bf(w_ffn_out[(size_t)k * D + n]); chk_fail(F.ctl, __any(bad)); }
        if (CHK_ON(9)) for (int i = 0; i < 4; ++i) { const unsigned h = hash_u32((unsigned)(gw * 101 + i + 9)); const int m = (int)(h % (unsigned)M), c = (int)((h >> 14) % 1024u), bb = m >> 13;
            const float e = x[(size_t)m * D + c] + MOD[(size_t)bb * (NMOD * D) + 2 * D + c] * wdot(MERGED + (size_t)m * 1024, w_out, D, D, c, F.lane) + MOD[(size_t)bb * (NMOD * D) + 5 * D + c] * wdot(Hb + (size_t)m * DFF, w_ffn_out, DFF, D, c, F.lane);
            chk_fail(F.ctl, far(out[(size_t)m * D + c], e, 2e-2f, 2e-2f)); }
        GRID_BAR();
#endif
        const bool poison = (__hip_atomic_load(F.ctl + CW_TMO, RLX_AGENT) != 0u) || (__hip_atomic_load((gu32*)((unsigned*)(F.ctl + CW_BAR) + XB_TMO), RLX_AGENT) != 0u) || (__hip_atomic_load(F.ctl + CW_CHK, RLX_AGENT) != 0u) || (__hip_atomic_load(F.ctl + 3, RLX_AGENT) >= (unsigned)CNT_THRESH);
        for (int i = 0; i < 8; ++i) { const int m = F.vcu * 64 + F.wave * 8 + i;
            GAS f32x4* xr = (GAS f32x4*)(out + (size_t)m * D) + F.lane; f32x4 v[4]; float s2 = 0.f;
#pragma unroll
            for (int j = 0; j < 4; ++j) { v[j] = xr[64 * j]; s2 += (v[j].x * v[j].x + v[j].y * v[j].y) + (v[j].z * v[j].z + v[j].w * v[j].w); }
            const float rstd = 1.f / sqrtf(wave_sum(s2) * (1.f / D) + EPS);
#pragma unroll
            for (int j = 0; j < 4; ++j) { const f32x4 gv = *(const f32x4*)(norm_final_g + 4 * F.lane + 256 * j); f32x4 y = v[j] * rstd * gv;
                if (poison) { const float q = __builtin_nanf(""); y = (f32x4){q, q, q, q}; } xr[64 * j] = y; } }
    }
#undef IN
#undef BOTH
#undef GRID_BAR
}

extern "C" void kernel_launch(void* const* d_in, const int* in_sizes, int n_in, void* d_out, int out_size, void* d_ws, size_t ws_size, hipStream_t stream) {
    static int grid = 0;
    if (grid == 0) {
        if (n_in != 17 || in_sizes[0] != M * D || out_size != M * D || ws_size < WS_END) { fprintf(stderr, "kernel_launch: unexpected problem shape (n_in %d, in0 %d, out %d, ws %zu); nothing launched\n", n_in, n_in > 0 ? in_sizes[0] : -1, out_size, ws_size); grid = -1; return; }
        int dev = 0, cus = 0, per_cu = 0;
        if (hipGetDevice(&dev) != hipSuccess || hipDeviceGetAttribute(&cus, hipDeviceAttributeMultiprocessorCount, dev) != hipSuccess) { fprintf(stderr, "kernel_launch: device query failed\n"); grid = -1; return; }
        if (hipFuncSetAttribute((const void*)mk_fwd, hipFuncAttributeMaxDynamicSharedMemorySize, LDS_BYTES) != hipSuccess) { fprintf(stderr, "kernel_launch: hipFuncSetAttribute failed\n"); grid = -1; return; }
        if (hipOccupancyMaxActiveBlocksPerMultiprocessor(&per_cu, (const void*)mk_fwd, NWAVES * 64, LDS_BYTES) != hipSuccess || per_cu < 1)
            fprintf(stderr, "kernel_launch: note: occupancy query reports %d workgroups per CU\n", per_cu);
        (void)hipGetLastError();
        grid = cus;
        if (grid != 256) fprintf(stderr, "kernel_launch: %d CUs; this kernel is built for 256\n", grid);
    }
    if (grid < 0) return;
    if (hipMemsetAsync((char*)d_ws + WS_CTL, 0, CTL_ZERO_BYTES, stream) != hipSuccess) { fprintf(stderr, "kernel_launch: hipMemsetAsync failed\n"); return; }
    Args a{};
    for (int i = 0; i < 17; ++i) a.in[i] = (const float*)d_in[i];
    a.out = (float*)d_out; a.ws = (unsigned char*)d_ws; a.ph_lo = 0; a.ph_hi = N_PHASES;
#if defined(ALIAS_CHECK)
    { const uintptr_t w0 = (uintptr_t)d_ws, w1 = w0 + (uintptr_t)WS_END; unsigned long long f = 0ull;
      for (int i = 0; i < 17; ++i) { const uintptr_t p0 = (uintptr_t)d_in[i], p1 = p0 + (uintptr_t)in_sizes[i] * 4; if (p0 < w1 && p1 > w0) f |= 1ull << i; }
      { const uintptr_t p0 = (uintptr_t)d_out, p1 = p0 + (uintptr_t)out_size * 4; if (p0 < w1 && p1 > w0) f |= 1ull << 20; }
      a.flags = f; }
#endif
#if defined(TWOLAUNCH)
#if defined(TWOLAUNCH_WARM)
    a.flags = 2ull; a.ph_lo = 0; a.ph_hi = TWOLAUNCH_PH + 1;
    hipLaunchKernelGGL(mk_fwd, dim3(grid), dim3(NWAVES * 64), LDS_BYTES, stream, a);
    (void)hipMemsetAsync((char*)d_ws + WS_CTL, 0, CTL_ZERO_BYTES, stream);
#endif
    a.flags = 0ull; a.ph_lo = 0; a.ph_hi = TWOLAUNCH_PH + 1;
    hipLaunchKernelGGL(mk_fwd, dim3(grid), dim3(NWAVES * 64), LDS_BYTES, stream, a);
    (void)hipMemsetAsync((char*)d_ws + WS_CTL + 64, 0, CTL_ZERO_BYTES - 64, stream);
    a.flags = 1ull; a.ph_lo = 0; a.ph_hi = N_PHASES;
#endif
    hipLaunchKernelGGL(mk_fwd, dim3(grid), dim3(NWAVES * 64), LDS_BYTES, stream, a);
    const hipError_t le = hipPeekAtLastError();
    if (le != hipSuccess) fprintf(stderr, "kernel_launch: launch failed: %s\n", hipGetErrorName(le));
}
```

```cpp
#include <hip/hip_runtime.h>
#include <cstdio>
#include <cstdint>

namespace pg8 {
#define PG8_LAS __attribute__((address_space(3)))
typedef unsigned short bf16_t;
typedef short bf16x8 __attribute__((ext_vector_type(8)));
typedef float f32x4 __attribute__((ext_vector_type(4)));
typedef unsigned u32x4 __attribute__((ext_vector_type(4)));
constexpr int BM = 256, BK = 64, HALF = 128, HTB = HALF * BK * 2  , STAGE_BYTES = 8 * HTB, NXCD = 8, WGM = 8;

__host__ __device__ __forceinline__ int lds_byte(int r, int c) { const int st = (r >> 4) * 2 + (c >> 5), rr = r & 15, cc = c & 31, ob = rr * 64 + cc * 2; return st * 1024 + (ob ^ (((ob >> 9) & 1) << 5)); }
__host__ __device__ __forceinline__ void stage_rc(int b, int& R, int& C) { const int st = b / 1024, sb = b % 1024, swz = sb ^ (((sb >> 9) & 1) << 5); R = (st >> 1) * 16 + swz / 64; C = (st & 1) * 32 + (swz % 64) / 2; }
__host__ __device__ __forceinline__ int perm32(int rho) { const int n = rho >> 4, i = rho & 15; return 8 * (i >> 2) + 4 * n + (i & 3); }

struct Unit { int pm, pn; };
struct Gemm { const bf16_t* A; const bf16_t* Bt; int M, N, K; };

struct StaticOrder {
    int nM, nN, nwg, G, c;
    __host__ __device__ void init(int M, int N, int G_, int c_) { nM = M / BM; nN = N / BM; nwg = nM * nN; G = G_; c = c_; }
    __host__ __device__ bool next(int i, Unit& u) const {
        const long L = (long)i * G + c; if (L >= nwg) return false;
        int wgid = (int)L; { const int q = nwg / NXCD, r = nwg % NXCD, xcd = wgid % NXCD, off = wgid / NXCD; wgid = (xcd < r ? xcd * (q + 1) : r * (q + 1) + (xcd - r) * q) + off; }
        const int nig = WGM * nN, gid = wgid / nig, fm = gid * WGM, gsz = (nM - fm) < WGM ? (nM - fm) : WGM;
        u.pm = fm + ((wgid % nig) % gsz); u.pn = (wgid % nig) / gsz; return true;
    }
    __device__ __forceinline__ void a_ready(const Unit&) const {}
    __device__ __forceinline__ void done(const Unit&) const {}
};

typedef float f32x2_cv __attribute__((ext_vector_type(2))); typedef __bf16 bf16x2_cv __attribute__((ext_vector_type(2)));
__device__ __forceinline__ unsigned cvt_pk_bf16(float lo, float hi) { const f32x2_cv v = {lo, hi}; const bf16x2_cv b = __builtin_convertvector(v, bf16x2_cv); return __builtin_bit_cast(unsigned, b); }
__device__ __forceinline__ float sigm(float x) { return __builtin_amdgcn_rcpf(1.0f + __builtin_amdgcn_exp2f(-1.4426950408889634f * x)); }
__device__ __forceinline__ float bf_lo(unsigned w) { return __builtin_bit_cast(float, w << 16); }
__device__ __forceinline__ float bf_hi(unsigned w) { return __builtin_bit_cast(float, w & 0xffff0000u); }
__device__ __forceinline__ u32x4 pack8(f32x4 v0, f32x4 v1) { u32x4 w; w.x = cvt_pk_bf16(v0[0], v0[1]); w.y = cvt_pk_bf16(v0[2], v0[3]); w.z = cvt_pk_bf16(v1[0], v1[1]); w.w = cvt_pk_bf16(v1[2], v1[3]); return w; }
constexpr float QSCALE = 0.125f * 1.4426950408889634f;

struct EpiInProj {
    static constexpr bool PERM = true, AFTER_DRAIN = false;
    bf16_t *Q, *K, *V, *QI, *Z, *SGA, *SGB, *KI; float* WI;
    __device__ __forceinline__ void operator()(const f32x4 (&acc)[2][2][4][2], const Unit& u, int wr, int wc, int fr, int fq) const {
        const int pn = u.pn; const int row0 = u.pm * BM + wr * 64 + fr;
        if (pn < 8) {
            bf16_t* base = (pn < 2) ? Q : (pn < 4) ? K : (pn < 6) ? V : QI; const float sc = (pn < 2) ? QSCALE : 1.0f;
            const int col0 = (pn & 1) * 256 + wc * 32 + 8 * fq;
#pragma unroll
            for (int ai = 0; ai < 2; ++ai)
#pragma unroll
                for (int m = 0; m < 4; ++m) { bf16_t* rowp = base + (size_t)(row0 + ai * HALF + m * 16) * 512 + col0;
#pragma unroll
                    for (int bj = 0; bj < 2; ++bj) *(u32x4*)(rowp + bj * HALF) = pack8(acc[ai][bj][m][0] * sc, acc[ai][bj][m][1] * sc); }
        } else if (pn < 12) {
            const int col0 = (pn - 8) * 128 + wc * 32 + 8 * fq;
#pragma unroll
            for (int ai = 0; ai < 2; ++ai)
#pragma unroll
                for (int m = 0; m < 4; ++m) { f32x4 z0, z1;
#pragma unroll
                    for (int e = 0; e < 4; ++e) { z0[e] = acc[ai][0][m][0][e] * sigm(acc[ai][1][m][0][e]); z1[e] = acc[ai][0][m][1][e] * sigm(acc[ai][1][m][1][e]); }
                    *(u32x4*)(Z + (size_t)(row0 + ai * HALF + m * 16) * 512 + col0) = pack8(z0, z1); }
        } else if (pn < 20) {
            bf16_t* base = (pn < 16) ? SGA : SGB; const int col0 = ((pn - 12) & 3) * 256 + wc * 32 + 8 * fq;
#pragma unroll
            for (int ai = 0; ai < 2; ++ai)
#pragma unroll
                for (int m = 0; m < 4; ++m) { bf16_t* rowp = base + (size_t)(row0 + ai * HALF + m * 16) * 1024 + col0;
#pragma unroll
                    for (int bj = 0; bj < 2; ++bj) { f32x4 s0, s1;
#pragma unroll
                        for (int e = 0; e < 4; ++e) { s0[e] = sigm(acc[ai][bj][m][0][e]); s1[e] = sigm(acc[ai][bj][m][1][e]); }
                        *(u32x4*)(rowp + bj * HALF) = pack8(s0, s1); } }
        } else {
            if (wc < 2) {
#pragma unroll
                for (int ai = 0; ai < 2; ++ai)
#pragma unroll
                    for (int m = 0; m < 4; ++m) *(u32x4*)(KI + (size_t)(row0 + ai * HALF + m * 16) * 64 + wc * 32 + 8 * fq) = pack8(acc[ai][0][m][0], acc[ai][0][m][1]);
            } else if (wc == 2 && fq == 0) {
#pragma unroll
                for (int ai = 0; ai < 2; ++ai)
#pragma unroll
                    for (int m = 0; m < 4; ++m) { float* p = WI + (size_t)(row0 + ai * HALF + m * 16) * 8; *(f32x4*)p = acc[ai][0][m][0]; *(f32x4*)(p + 4) = acc[ai][0][m][1]; }
            }
        }
    }
};
template <int MODE> struct EpiGate {
    static constexpr bool PERM = true, AFTER_DRAIN = false;
    const bf16_t* G; bf16_t* T; const bf16_t* Tin;
    __device__ __forceinline__ void operator()(const f32x4 (&acc)[2][2][4][2], const Unit& u, int wr, int wc, int fr, int fq) const {
        const int row0 = u.pm * BM + wr * 64 + fr, col0 = u.pn * BM + wc * 32 + 8 * fq;
#pragma unroll
        for (int ai = 0; ai < 2; ++ai)
#pragma unroll
            for (int m = 0; m < 4; ++m) { const size_t off = (size_t)(row0 + ai * HALF + m * 16) * 1024 + col0;
#pragma unroll
                for (int bj = 0; bj < 2; ++bj) { const u32x4 g = *(const u32x4*)(G + off + bj * HALF);
                    f32x4 v0 = acc[ai][bj][m][0], v1 = acc[ai][bj][m][1];
                    v0[0] *= bf_lo(g.x); v0[1] *= bf_hi(g.x); v0[2] *= bf_lo(g.y); v0[3] *= bf_hi(g.y); v1[0] *= bf_lo(g.z); v1[1] *= bf_hi(g.z); v1[2] *= bf_lo(g.w); v1[3] *= bf_hi(g.w);
                    if (MODE == 1) { const u32x4 t = *(const u32x4*)(Tin + off + bj * HALF);
                        v0[0] += bf_lo(t.x); v0[1] += bf_hi(t.x); v0[2] += bf_lo(t.y); v0[3] += bf_hi(t.y); v1[0] += bf_lo(t.z); v1[1] += bf_hi(t.z); v1[2] += bf_lo(t.w); v1[3] += bf_hi(t.w); }
                    *(u32x4*)(T + off + bj * HALF) = pack8(v0, v1); } }
    }
};
struct EpiResid {
    static constexpr bool PERM = false, AFTER_DRAIN = false;
    const float* base; float* out; const float* gate; int gstride;
    __device__ __forceinline__ void operator()(const f32x4 (&acc)[2][2][4][2], const Unit& u, int wr, int wc, int fr, int fq) const {
        const int row0 = u.pm * BM + wr * 64 + fr, col0 = u.pn * BM + wc * 32 + 4 * fq;
        const float* gp = gate + ((u.pm * BM) >= 8192 ? gstride : 0) + col0;
        f32x4 gv[2][2];
#pragma unroll
        for (int bj = 0; bj < 2; ++bj)
#pragma unroll
            for (int n = 0; n < 2; ++n) gv[bj][n] = *(const f32x4*)(gp + bj * HALF + n * 16);
#pragma unroll
        for (int ai = 0; ai < 2; ++ai)
#pragma unroll
            for (int m = 0; m < 4; ++m) { const size_t off = (size_t)(row0 + ai * HALF + m * 16) * 1024 + col0;
#pragma unroll
                for (int bj = 0; bj < 2; ++bj)
#pragma unroll
                    for (int n = 0; n < 2; ++n) { const f32x4 bs = *(const f32x4*)(base + off + bj * HALF + n * 16); *(f32x4*)(out + off + bj * HALF + n * 16) = bs + gv[bj][n] * acc[ai][bj][m][n]; } }
    }
};
struct EpiSwiGLU {
    static constexpr bool PERM = true, AFTER_DRAIN = false;
    bf16_t* H; int ldh;
    __device__ __forceinline__ void operator()(const f32x4 (&acc)[2][2][4][2], const Unit& u, int wr, int wc, int fr, int fq) const {
        const int row0 = u.pm * BM + wr * 64 + fr, col0 = u.pn * 128 + wc * 32 + 8 * fq;
#pragma unroll
        for (int ai = 0; ai < 2; ++ai)
#pragma unroll
            for (int m = 0; m < 4; ++m) { f32x4 h0, h1;
#pragma unroll
                for (int e = 0; e < 4; ++e) { const float a0 = acc[ai][0][m][0][e], a1 = acc[ai][0][m][1][e]; h0[e] = a0 * sigm(a0) * acc[ai][1][m][0][e]; h1[e] = a1 * sigm(a1) * acc[ai][1][m][1][e]; }
                *(u32x4*)(H + (size_t)(row0 + ai * HALF + m * 16) * ldh + col0) = pack8(h0, h1); }
    }
};

template <class Epi, class Sched, bool ALIGN_EPI = false, bool SP2 = false>
__device__ __forceinline__ void gemm_phase(PG8_LAS unsigned char* lds, const Gemm g, const Sched& S, const Epi& E) {
    const int tid = threadIdx.x, wid = __builtin_amdgcn_readfirstlane(tid >> 6), lane = tid & 63, wr = wid >> 2, wc = wid & 3, fr = lane & 15, fq = lane >> 4;
    const int K = g.K, nt = K / BK;
    unsigned voffA[2], voffB[2];
#pragma unroll
    for (int i = 0; i < 2; ++i) { int R, C; stage_rc(tid * 16 + i * 8192, R, C); const int Rb = Epi::PERM ? ((R & ~31) + perm32(R & 31)) : R;
        voffA[i] = (unsigned)(R * K + C) * 2u; voffB[i] = (unsigned)(Rb * K + C) * 2u; }
    const size_t kstep = (size_t)(BK * 2);
    const size_t hstep = (size_t)HALF * K * 2;
    const size_t tstep = 2 * hstep;
    const unsigned ldsw = (unsigned)wid * 1024u;
    const int aoff = lds_byte(wr * 64 + fr, fq * 8), boff = lds_byte(wc * 32 + fr, fq * 8);
#define PG8_SA(b, h) (((b) * 2 + (h)) * HTB)
#define PG8_SB(b, h) ((4 + (b) * 2 + (h)) * HTB)
#define PG8_STAGE(bufoff, gbase, voff) do { _Pragma("unroll") for (int _i = 0; _i < 2; ++_i) \
        __builtin_amdgcn_global_load_lds((const unsigned*)((const char*)(gbase) + (voff)[_i]), (PG8_LAS unsigned*)(lds + (bufoff) + ldsw + _i * 8192), 16, 0, 0); } while (0)
#define PG8_LDA(dst, b, h) do { _Pragma("unroll") for (int m = 0; m < 4; ++m) _Pragma("unroll") for (int k = 0; k < 2; ++k) dst[m][k] = *(const PG8_LAS bf16x8*)(lds + PG8_SA(b, h) + aoff + m * 2048 + k * 1024); } while (0)
#define PG8_LDB(dst, b, h) do { _Pragma("unroll") for (int n = 0; n < 2; ++n) _Pragma("unroll") for (int k = 0; k < 2; ++k) dst[n][k] = *(const PG8_LAS bf16x8*)(lds + PG8_SB(b, h) + boff + n * 2048 + k * 1024); } while (0)
#define PG8_MMA(ai, bj, At, Bt) do { __builtin_amdgcn_s_setprio(1); _Pragma("unroll") for (int m = 0; m < 4; ++m) _Pragma("unroll") for (int n = 0; n < 2; ++n) _Pragma("unroll") for (int k = 0; k < 2; ++k) \
        acc[ai][bj][m][n] = __builtin_amdgcn_mfma_f32_16x16x32_bf16(Bt[n][k], At[m][k], acc[ai][bj][m][n], 0, 0, 0); __builtin_amdgcn_s_setprio(0); } while (0)
#if defined(GEMM_DRAIN)
#define PG8_WAIT_V(n) asm volatile("s_waitcnt vmcnt(0)" ::: "memory")
#else
#define PG8_WAIT_V(n) asm volatile("s_waitcnt vmcnt(" #n ")" ::: "memory")
#endif
#define PG8_WAIT_L(n) asm volatile("s_waitcnt lgkmcnt(" #n ")" ::: "memory")
#define PG8_BAR __builtin_amdgcn_s_barrier()
#define PG8_SCHED __builtin_amdgcn_sched_barrier(0)
    Unit cur, nxt; int ui = 0;
    if (!S.next(0, cur)) return;
    f32x4 acc[2][2][4][2];
#pragma unroll
    for (int a = 0; a < 2; ++a)
#pragma unroll
        for (int b = 0; b < 2; ++b)
#pragma unroll
            for (int m = 0; m < 4; ++m)
#pragma unroll
                for (int n = 0; n < 2; ++n) acc[a][b][m][n] = (f32x4){0.f, 0.f, 0.f, 0.f};
    bf16x8 At[4][2], B0[2][2], B1[2][2];
    const char* cA = (const char*)g.A + (size_t)cur.pm * tstep; const char* cB = (const char*)g.Bt + (size_t)cur.pn * tstep;
    S.a_ready(cur);
    if constexpr (SP2) {
        PG8_STAGE(PG8_SB(0, 0), cB, voffB); PG8_STAGE(PG8_SB(0, 1), cB + hstep, voffB); PG8_STAGE(PG8_SA(0, 0), cA, voffA); PG8_STAGE(PG8_SA(0, 1), cA + hstep, voffA);
        if (wr == 1) PG8_BAR;
        PG8_WAIT_V(2); PG8_BAR;
        PG8_STAGE(PG8_SB(1, 0), cB + kstep, voffB); PG8_STAGE(PG8_SA(1, 0), cA + kstep, voffA); PG8_STAGE(PG8_SB(1, 1), cB + hstep + kstep, voffB);
        PG8_WAIT_V(6); PG8_BAR;
    } else {
        PG8_STAGE(PG8_SB(0, 0), cB, voffB); PG8_STAGE(PG8_SA(0, 0), cA, voffA); PG8_STAGE(PG8_SB(0, 1), cB + hstep, voffB); PG8_STAGE(PG8_SA(0, 1), cA + hstep, voffA);
        if (wr == 1) PG8_BAR;
        PG8_WAIT_V(4); PG8_BAR;
        PG8_STAGE(PG8_SB(1, 0), cB + kstep, voffB); PG8_STAGE(PG8_SA(1, 0), cA + kstep, voffA); PG8_STAGE(PG8_SB(1, 1), cB + hstep + kstep, voffB);
        PG8_WAIT_V(6); PG8_BAR;
    }
    for (;;) {
        const bool has_next = S.next(ui + 1, nxt);
        const char* nA = has_next ? (const char*)g.A + (size_t)nxt.pm * tstep : cA; const char* nB = has_next ? (const char*)g.Bt + (size_t)nxt.pn * tstep : cB;
        for (int t = 0; t < nt; t += 2) {
            const bool last = (t == nt - 2);
            const char* a1 = cA + (size_t)(t + 1) * kstep;
            const char* a2 = last ? nA : cA + (size_t)(t + 2) * kstep; const char* b2 = last ? nB : cB + (size_t)(t + 2) * kstep;
            const char* a3 = a2 + kstep; const char* b3 = b2 + kstep;
            if (last && has_next) S.a_ready(nxt);
            if constexpr (SP2) {
            PG8_LDB(B0, 0, 0); PG8_LDB(B1, 0, 1); PG8_SCHED; PG8_LDA(At, 0, 0); PG8_STAGE(PG8_SA(1, 1), a1 + hstep, voffA);
            PG8_WAIT_V(8); PG8_WAIT_L(0); PG8_BAR; PG8_MMA(0, 0, At, B0); PG8_MMA(0, 1, At, B1); PG8_BAR; PG8_SCHED;
            PG8_LDA(At, 0, 1); PG8_STAGE(PG8_SB(0, 0), b2, voffB); PG8_STAGE(PG8_SB(0, 1), b2 + hstep, voffB); PG8_STAGE(PG8_SA(0, 0), a2, voffA);
            PG8_WAIT_V(8); PG8_WAIT_L(0); PG8_BAR; PG8_MMA(1, 0, At, B0); PG8_MMA(1, 1, At, B1); PG8_BAR; PG8_SCHED;
            PG8_LDB(B0, 1, 0); PG8_LDB(B1, 1, 1); PG8_SCHED; PG8_LDA(At, 1, 0); PG8_STAGE(PG8_SA(0, 1), a2 + hstep, voffA);
            PG8_WAIT_V(8); PG8_WAIT_L(0); PG8_BAR; PG8_MMA(0, 0, At, B0); PG8_MMA(0, 1, At, B1); PG8_BAR; PG8_SCHED;
            PG8_LDA(At, 1, 1); PG8_STAGE(PG8_SB(1, 0), b3, voffB); PG8_STAGE(PG8_SB(1, 1), b3 + hstep, voffB); PG8_STAGE(PG8_SA(1, 0), a3, voffA);
            PG8_WAIT_V(8); PG8_WAIT_L(0); PG8_BAR; PG8_MMA(1, 0, At, B0); PG8_MMA(1, 1, At, B1); PG8_BAR; PG8_SCHED;
            } else {
            PG8_LDB(B0, 0, 0); PG8_SCHED; PG8_LDA(At, 0, 0); PG8_STAGE(PG8_SA(1, 1), a1 + hstep, voffA);
            PG8_WAIT_L(8); PG8_BAR; PG8_WAIT_L(0); PG8_MMA(0, 0, At, B0); PG8_BAR; PG8_SCHED;
            PG8_LDB(B1, 0, 1); PG8_STAGE(PG8_SB(0, 0), b2, voffB);
            PG8_BAR; PG8_WAIT_L(0); PG8_MMA(0, 1, At, B1); PG8_BAR;
            PG8_LDA(At, 0, 1); PG8_STAGE(PG8_SA(0, 0), a2, voffA);
            PG8_BAR; PG8_WAIT_L(0); PG8_MMA(1, 0, At, B0); PG8_BAR; PG8_SCHED;
            PG8_STAGE(PG8_SB(0, 1), b2 + hstep, voffB);
            PG8_WAIT_V(6); PG8_BAR; PG8_MMA(1, 1, At, B1); PG8_BAR;
            PG8_LDB(B0, 1, 0); PG8_SCHED; PG8_LDA(At, 1, 0); PG8_STAGE(PG8_SA(0, 1), a2 + hstep, voffA);
            PG8_WAIT_L(8); PG8_BAR; PG8_WAIT_L(0); PG8_MMA(0, 0, At, B0); PG8_BAR; PG8_SCHED;
            PG8_LDB(B1, 1, 1); PG8_STAGE(PG8_SB(1, 0), b3, voffB);
            PG8_BAR; PG8_WAIT_L(0); PG8_MMA(0, 1, At, B1); PG8_BAR;
            PG8_LDA(At, 1, 1); PG8_STAGE(PG8_SA(1, 0), a3, voffA);
            PG8_BAR; PG8_WAIT_L(0); PG8_MMA(1, 0, At, B0); PG8_BAR; PG8_SCHED;
            PG8_STAGE(PG8_SB(1, 1), b3 + hstep, voffB);
            PG8_WAIT_V(6); PG8_BAR; PG8_MMA(1, 1, At, B1); PG8_BAR;
            }
        }
        if constexpr (ALIGN_EPI) { if (wr == 0) PG8_BAR; }
        if constexpr (!Epi::AFTER_DRAIN) { E(acc, cur, wr, wc, fr, fq); S.done(cur); }
        if (!has_next) break;
#pragma unroll
        for (int a = 0; a < 2; ++a)
#pragma unroll
            for (int b = 0; b < 2; ++b)
#pragma unroll
                for (int m = 0; m < 4; ++m)
#pragma unroll
                    for (int n = 0; n < 2; ++n) acc[a][b][m][n] = (f32x4){0.f, 0.f, 0.f, 0.f};
        cur = nxt; cA = nA; cB = nB; ++ui;
        if constexpr (ALIGN_EPI) { if (wr == 1) PG8_BAR; }
    }
    PG8_WAIT_V(0);
    if constexpr (!ALIGN_EPI) { if (wr == 0) PG8_BAR; }
    PG8_BAR;
    if constexpr (Epi::AFTER_DRAIN) { E.fused(acc, cur, wr, wc, fr, fq, lds, wid, lane); S.done(cur); }
#undef PG8_SA
#undef PG8_SB
#undef PG8_STAGE
#undef PG8_LDA
#undef PG8_LDB
#undef PG8_MMA
#undef PG8_WAIT_V
#undef PG8_WAIT_L
#undef PG8_BAR
#undef PG8_SCHED
}
}
#include <hip/hip_bf16.h>
#include <cmath>
namespace attn_body {
using bf16=__hip_bfloat16;
using bf16x8=__attribute__((ext_vector_type(8)))short;
using s16x4=__attribute__((ext_vector_type(4)))short;
using f32x16=__attribute__((ext_vector_type(16)))float;
using u32x4=__attribute__((ext_vector_type(4)))unsigned;
constexpr int BATCH=2,NHEAD=8,SEQ=8192,D=64,DM=NHEAD*D;
constexpr int NW=8,QBLK=32,QB=QBLK*NW,KVBLK=64,NQB=SEQ/QB;
constexpr int ATTN_PITCH=DM, ATTN_UNIT_ROWS=QB;
__device__ __forceinline__ int crow(int r,int hi){return (r&3)+8*(r>>2)+4*hi;}
#define SBAR() __builtin_amdgcn_sched_barrier(0)
__device__ __forceinline__ void cmask(f32x16&p0,f32x16&p1,int jb,int qrel,int hi){
  const float NEG=-INFINITY; int kb=64*jb+4*hi;
  #pragma unroll
  for(int r=0;r<16;++r){int kv=kb+(r&3)+8*(r>>2); if(kv>qrel)p0[r]=NEG; if(kv+32>qrel)p1[r]=NEG;}
}

constexpr int NSLOT=3, SLOTB=8192;
constexpr int LDS_K=0, LDS_V=NSLOT*SLOTB, LDS_WS=2*NSLOT*SLOTB, LDS_OST=LDS_WS+NW*64*4, LDS_BYTES=LDS_OST+NW*4096;
constexpr float C2=0.125f*1.4426950408889634f;
__device__ __forceinline__ void glds16(const void*gsrc,unsigned lds_dst){unsigned keep;
  asm volatile("s_mov_b32 %0, m0\n\ts_mov_b32 m0, %2\n\ts_nop 0\n\tglobal_load_lds_dwordx4 %1, off\n\ts_nop 7\n\ts_nop 7\n\ts_mov_b32 m0, %0":"=&s"(keep):"v"(gsrc),"s"(lds_dst):"memory");}
__device__ __forceinline__ float max3f(float a,float b,float c){float r;asm("v_max3_f32 %0, %1, %2, %3":"=v"(r):"v"(a),"v"(b),"v"(c));return r;}
__device__ __forceinline__ float max2f(float a,float b){float r;asm("v_max_f32_e32 %0, %1, %2":"=v"(r):"v"(a),"v"(b));return r;}
__device__ __forceinline__ float fadd_s(float a,float b){float r;asm("v_add_f32_e32 %0, %1, %2":"=v"(r):"v"(a),"v"(b));return r;}
__device__ __forceinline__ float fsub_s(float a,float b){float r;asm("v_sub_f32_e32 %0, %1, %2":"=v"(r):"v"(a),"v"(b));return r;}
typedef float f32x2_t __attribute__((ext_vector_type(2))); typedef __bf16 bf16x2_t __attribute__((ext_vector_type(2)));
__device__ __forceinline__ unsigned cvtpk_s(float lo,float hi){f32x2_t v={lo,hi};bf16x2_t b=__builtin_convertvector(v,bf16x2_t);return __builtin_bit_cast(unsigned,b);}
#if defined(ATT_DRAIN)
#define WAIT_BAR(N) asm volatile("s_waitcnt vmcnt(0) lgkmcnt(0)\n\ts_barrier":::"memory")
#else
#define WAIT_BAR(N) asm volatile("s_waitcnt vmcnt(" #N ") lgkmcnt(0)\n\ts_barrier":::"memory")
#endif

__device__ __forceinline__ void qkt(f32x16&p0,f32x16&p1,const char*Kslot,const bf16x8*qr,const f32x16&negm,int r32,int hi){
  const char*kb=Kslot+hi*1024+r32*16;
  #pragma unroll
  for(int d0=0;d0<4;++d0){
    const bf16x8 b0=*reinterpret_cast<const bf16x8*>(kb+d0*2048);
    const bf16x8 b1=*reinterpret_cast<const bf16x8*>(kb+d0*2048+512);
    if(d0==0){p0=__builtin_amdgcn_mfma_f32_32x32x16_bf16(b0,qr[0],negm,0,0,0);p1=__builtin_amdgcn_mfma_f32_32x32x16_bf16(b1,qr[0],negm,0,0,0);}
    else{p0=__builtin_amdgcn_mfma_f32_32x32x16_bf16(b0,qr[d0],p0,0,0,0);p1=__builtin_amdgcn_mfma_f32_32x32x16_bf16(b1,qr[d0],p1,0,0,0);}}
}
typedef __attribute__((address_space(3))) const char* lds_cptr;
typedef short v4i16_t __attribute__((ext_vector_type(4)));
__device__ __forceinline__ void kload8(bf16x8*kf,lds_cptr kp){
  kf[0]=*(const __attribute__((address_space(3))) bf16x8*)(kp);      kf[1]=*(const __attribute__((address_space(3))) bf16x8*)(kp+512);
  kf[2]=*(const __attribute__((address_space(3))) bf16x8*)(kp+2048); kf[3]=*(const __attribute__((address_space(3))) bf16x8*)(kp+2560);
  kf[4]=*(const __attribute__((address_space(3))) bf16x8*)(kp+4096); kf[5]=*(const __attribute__((address_space(3))) bf16x8*)(kp+4608);
  kf[6]=*(const __attribute__((address_space(3))) bf16x8*)(kp+6144); kf[7]=*(const __attribute__((address_space(3))) bf16x8*)(kp+6656);
}
__device__ __forceinline__ void kload2(bf16x8*kf,lds_cptr kp,int j){ kf[2*j]=*(const __attribute__((address_space(3))) bf16x8*)(kp+j*2048); kf[2*j+1]=*(const __attribute__((address_space(3))) bf16x8*)(kp+j*2048+512); }
__device__ __forceinline__ s16x4 vtr(lds_cptr p){ return __builtin_bit_cast(s16x4,__builtin_amdgcn_ds_read_tr16_b64_v4i16((__attribute__((address_space(3))) v4i16_t*)p)); }
__device__ __forceinline__ float rowmax(const f32x16&p0,const f32x16&p1){
  float a=max3f(p0[0],p0[1],p1[0]),b=max3f(p0[2],p0[3],p1[1]);a=max3f(a,p1[2],p1[3]);
  #pragma unroll
  for(int r=4;r<16;r+=4){a=max3f(a,p0[r],p0[r+1]);b=max3f(b,p0[r+2],p0[r+3]);a=max3f(a,p1[r],p1[r+1]);b=max3f(b,p1[r+2],p1[r+3]);}
  const float m=max2f(a,b);
  auto rr=__builtin_amdgcn_permlane32_swap(__float_as_uint(m),__float_as_uint(m),false,false);
  return max2f(__uint_as_float(rr[0]),__uint_as_float(rr[1]));
}
__device__ __forceinline__ void pv(f32x16*o,int vb,bf16x8 pa0,bf16x8 pa1,bf16x8 pa2,bf16x8 pa3){
  #pragma unroll
  for(int d0=0;d0<2;++d0){s16x4 lo[4],hi[4];
    #pragma unroll
    for(int ks=0;ks<4;++ks){
      asm volatile("ds_read_b64_tr_b16 %0,%1 offset:%c2":"=&v"(lo[ks]):"v"(vb),"i"(d0*4096+ks*1024):"memory");
      asm volatile("ds_read_b64_tr_b16 %0,%1 offset:%c2":"=&v"(hi[ks]):"v"(vb),"i"(d0*4096+ks*1024+512):"memory");}
    asm volatile("s_waitcnt lgkmcnt(0)":::"memory");SBAR();
    #define PK(k) (bf16x8){lo[k][0],lo[k][1],lo[k][2],lo[k][3],hi[k][0],hi[k][1],hi[k][2],hi[k][3]}
    o[d0]=__builtin_amdgcn_mfma_f32_32x32x16_bf16(pa0,PK(0),o[d0],0,0,0);
    o[d0]=__builtin_amdgcn_mfma_f32_32x32x16_bf16(pa1,PK(1),o[d0],0,0,0);
    o[d0]=__builtin_amdgcn_mfma_f32_32x32x16_bf16(pa2,PK(2),o[d0],0,0,0);
    o[d0]=__builtin_amdgcn_mfma_f32_32x32x16_bf16(pa3,PK(3),o[d0],0,0,0);
    #undef PK
  }
}

#ifndef ATTN_STORE16
#define ATTN_STORE16(p,v) (*(u32x4*)(p)=(v))
#endif
template<int THRL> __device__ __forceinline__ void attn_unit(int b,int h,int qb,const bf16*Q,const bf16*__restrict__ K,const bf16*__restrict__ V,bf16*O,const unsigned long long*MASKG,char*shm){
  const int tid=threadIdx.x,lane=tid&63,r32=lane&31,hi=lane>>5; const int wid=__builtin_amdgcn_readfirstlane(tid>>6);
  const long rowbase=(long)b*SEQ; const int q0=qb*QB;
  const bf16*Qw=Q+(rowbase+q0+wid*QBLK)*DM+h*D;
  const bf16*Kh=K+rowbase*DM+h*D,*Vh=V+rowbase*DM+h*D;
  const unsigned lds0=(unsigned)(uintptr_t)shm;
  float*wsf=(float*)(shm+LDS_WS)+wid*64;
  const bf16*ksrc=Kh+(long)lane*DM+wid*8;
  const bf16*vsrc=Vh+(long)(16*(wid&3)+(lane>>2))*DM+(wid>>2)*32+(lane&3)*8;
  const unsigned kdst=lds0+LDS_K+wid*1024, vdst=lds0+LDS_V+wid*1024;
  #define DMA_K(t,slot) glds16(ksrc+(long)(t)*KVBLK*DM,(unsigned)__builtin_amdgcn_readfirstlane(kdst+(slot)))
  #define DMA_V(t,slot) glds16(vsrc+(long)(t)*KVBLK*DM,(unsigned)__builtin_amdgcn_readfirstlane(vdst+(slot)))
  const int vb0=(int)(lds0+LDS_V)+((lane>>4)&1)*32+(lane&3)*8+(4*hi+((lane&15)>>2))*64;
  const char*Kbase=shm+LDS_K; bf16x8 kf[8];
  const lds_cptr shm3=(lds_cptr)shm; const lds_cptr kp0=shm3+LDS_K+hi*1024+r32*16; const lds_cptr vp0=shm3+LDS_V+((lane>>4)&1)*32+(lane&3)*8+(4*hi+((lane&15)>>2))*64;
  const int NT=(q0+QB)/KVBLK;
  DMA_K(0,0);DMA_V(0,0);DMA_K(1,SLOTB);
  bf16x8 qr[4];
  #pragma unroll
  for(int d0=0;d0<4;++d0)qr[d0]=*reinterpret_cast<const bf16x8*>(&Qw[(long)r32*DM+d0*16+hi*8]);
  float mhat=0.f,l_reg=0.f;f32x16 o[2];o[0]=f32x16{};o[1]=f32x16{};
  const f32x16 zero16=f32x16{};
#if defined(ATT_NOALIBI)
  const float slope2=0.f; const float s32=0.f;
#elif defined(ATT_SMALLSLOPE)
  const float slope2=0.00390625f*1.4426950408889634f; const float s32=32.f*slope2;
#else
  const float slope2=__builtin_amdgcn_exp2f(-(float)(h+1))*1.4426950408889634f; const float s32=32.f*slope2;
#endif
  float kvf=(float)(4*hi-(q0+wid*QBLK+r32));
  bool seen=false;
  const unsigned long long* mrow=MASKG+((size_t)((b*(SEQ/32)+qb*8+wid))*(SEQ/64))*32+r32;
  unsigned long long mw_cur=mrow[0];
  const float NEG=-INFINITY;
  #define MLOAD(t) do{ const int tn_=((t)+1<SEQ/64)?(t)+1:(SEQ/64-1); mw_cur=mrow[(size_t)tn_*32]; }while(0)
#if defined(ATT_DENSE)
  #define ATT_MASKWORD(t) ({ const int d_=(q0+wid*QBLK+r32)-64*(t); (d_>=63)?~0ull:((d_<0)?0ull:((2ull<<d_)-1ull)); })
#else
  #define ATT_MASKWORD(t) (mw_cur)
#endif
  #define MSEL(X,W,c) __builtin_bit_cast(float,(__builtin_bit_cast(unsigned,(X))&(unsigned)(((int)((W)<<(31-(c))))>>31))|(~(unsigned)(((int)((W)<<(31-(c))))>>31)&0xFF800000u))
  #define MASKALIBI(P0,P1,t) do{ const float b0_=__builtin_fmaf(slope2,kvf,-mhat),b1_=b0_+s32; \
    const unsigned long long mwx_=ATT_MASKWORD(t); const unsigned wl_=((unsigned)mwx_)>>(4*hi), wh_=((unsigned)(mwx_>>32))>>(4*hi); \
    _Pragma("unroll") for(int r=0;r<16;++r){ const float x_=P0[r]+__builtin_fmaf(slope2,(float)((r&3)+8*(r>>2)),b0_); P0[r]=MSEL(x_,wl_,(r&3)+8*(r>>2)); } \
    _Pragma("unroll") for(int r=0;r<16;++r){ const float x_=P1[r]+__builtin_fmaf(slope2,(float)((r&3)+8*(r>>2)),b1_); P1[r]=MSEL(x_,wh_,(r&3)+8*(r>>2)); } \
    kvf+=64.f; }while(0)
  #define CMASK(P0,P1,t) MASKALIBI(P0,P1,t)
  bool resc=false;
  #define START(P0,P1) do{ const float rm=rowmax(P0,P1); resc=false; seen=(rm>NEG); \
    { const float dl=seen?rm:0.f; mhat=dl; \
      _Pragma("unroll") for(int r=0;r<16;++r){P0[r]=P0[r]-dl;P1[r]=P1[r]-dl;} } \
    _Pragma("unroll") for(int r=0;r<16;++r)P0[r]=__builtin_amdgcn_exp2f(P0[r]); }while(0)
  #define RESC() do{ if(resc){ asm volatile("s_waitcnt lgkmcnt(0)":::"memory"); \
      _Pragma("unroll") for(int d_=0;d_<2;++d_) _Pragma("unroll") for(int r=0;r<16;++r)o[d_][r]*=wsf[crow(r,hi)]; } }while(0)
  f32x16 pA0,pA1,pB0,pB1;
  int sl_prev=0,sl_cur=0,sl_next=SLOTB;
  #define ROT() do{sl_prev=sl_cur;sl_cur=sl_next;sl_next=(sl_next==(NSLOT-1)*SLOTB)?0:sl_next+SLOTB;}while(0)
  DMA_K(2,2*SLOTB);
  WAIT_BAR(3);
  qkt(pA0,pA1,Kbase,qr,zero16,r32,hi);asm volatile("s_nop 15\n\ts_nop 7":"+v"(pA0),"+v"(pA1));CMASK(pA0,pA1,0);MLOAD(0);
  START(pA0,pA1);
  _Pragma("unroll") for(int r=0;r<16;++r)pA1[r]=__builtin_amdgcn_exp2f(pA1[r]);
  WAIT_BAR(0);
  DMA_K(3,0);DMA_V(1,SLOTB);
  ROT();
  kload8(kf,kp0+sl_cur);
  WAIT_BAR(2);
  s16x4 vlo[8],vhi[8]; u32x4 pw0,pw1,pw2,pw3;
  #define PKW(P,B) cvtpk_s(P[B],P[B+1])
  #define PAF(k) __builtin_bit_cast(bf16x8,pw##k)
  #define VFR(i) (bf16x8){vlo[i][0],vlo[i][1],vlo[i][2],vlo[i][3],vhi[i][0],vhi[i][1],vhi[i][2],vhi[i][3]}
  #define PIN(x) asm volatile("":"+v"(x))
  #define MX3(a,b,c) __builtin_fmaxf(__builtin_fmaxf((a),(b)),(c))
  #define GAPA(MF,A0,A1,A2,A3,W0,W1,PW) do{ MF; sacc+=A0; sacc+=A1; sacc+=A2; sacc+=A3; PIN(sacc); W0; W1; PIN(PW); SBAR(); }while(0)
  #define EX(v) __builtin_amdgcn_exp2f(v)
  #define GAPB(MF,X,B) do{ MF; X[B]=EX(X[B]); X[B+1]=EX(X[B+1]); X[B+2]=EX(X[B+2]); X[B+3]=EX(X[B+3]); PIN(X); SBAR(); }while(0)
  #define VRD(i) do{ vlo[i]=vtr(vp_+(((i)>>2)*4096+((i)&3)*1024)); vhi[i]=vtr(vp_+(((i)>>2)*4096+((i)&3)*1024+512)); }while(0)
  #define KRD(G,j) do{ if(G){ kload2(kf,kp0+sl_next,j); SBAR(); } }while(0)
  #define STEP(C0,C1,P0,P1,t,GK,GV,GL) do{ SBAR(); \
    const lds_cptr vp_=vp0+sl_prev; \
    VRD(0); SBAR(); float sacc=(P0[0]+P0[1]); \
    GAPA(C0=__builtin_amdgcn_mfma_f32_32x32x16_bf16(kf[0],qr[0],zero16,0,0,0), P0[2],P0[3],P0[4],P0[5],     pw0[0]=PKW(P0,0), pw0[1]=PKW(P0,2), pw0); \
    VRD(4); SBAR(); GAPA(C1=__builtin_amdgcn_mfma_f32_32x32x16_bf16(kf[1],qr[0],zero16,0,0,0), P0[6],P0[7],P0[8],P0[9],     pw0[2]=PKW(P0,4), pw0[3]=PKW(P0,6), pw0); \
    VRD(1); SBAR(); GAPA(C0=__builtin_amdgcn_mfma_f32_32x32x16_bf16(kf[2],qr[1],C0,0,0,0),   P0[10],P0[11],P0[12],P0[13], pw1[0]=PKW(P0,8), pw1[1]=PKW(P0,10), pw1); \
    VRD(5); SBAR(); GAPA(C1=__builtin_amdgcn_mfma_f32_32x32x16_bf16(kf[3],qr[1],C1,0,0,0),   P0[14],P0[15],P1[0],P1[1],   pw1[2]=PKW(P0,12),pw1[3]=PKW(P0,14), pw1); \
    VRD(2); SBAR(); GAPA(C0=__builtin_amdgcn_mfma_f32_32x32x16_bf16(kf[4],qr[2],C0,0,0,0),   P1[2],P1[3],P1[4],P1[5],     pw2[0]=PKW(P1,0), pw2[1]=PKW(P1,2), pw2); \
    VRD(6); SBAR(); GAPA(C1=__builtin_amdgcn_mfma_f32_32x32x16_bf16(kf[5],qr[2],C1,0,0,0),   P1[6],P1[7],P1[8],P1[9],     pw2[2]=PKW(P1,4), pw2[3]=PKW(P1,6), pw2); \
    VRD(3); SBAR(); GAPA(C0=__builtin_amdgcn_mfma_f32_32x32x16_bf16(kf[6],qr[3],C0,0,0,0),   P1[10],P1[11],P1[12],P1[13], pw3[0]=PKW(P1,8), pw3[1]=PKW(P1,10), pw3); \
    VRD(7); SBAR(); GAPA(C1=__builtin_amdgcn_mfma_f32_32x32x16_bf16(kf[7],qr[3],C1,0,0,0),   P1[14],P1[15],0.f,0.f,       pw3[2]=PKW(P1,12),pw3[3]=PKW(P1,14), pw3); \
    l_reg+=sacc; \
    CMASK(C0,C1,t); asm volatile("":"+v"(C0),"+v"(C1)); MLOAD(t); \
    if(GK){DMA_K((t)+3,sl_cur);} if(GV){DMA_V((t)+1,sl_next);} \
    { float a=MX3(C0[0],C0[1],C1[0]),b=MX3(C0[2],C0[3],C1[1]); a=MX3(a,C1[2],C1[3]); \
      _Pragma("unroll") for(int r=4;r<16;r+=4){a=MX3(a,C0[r],C0[r+1]);b=MX3(b,C0[r+2],C0[r+3]);a=MX3(a,C1[r],C1[r+1]);b=MX3(b,C1[r+2],C1[r+3]);} \
      float rm=__builtin_fmaxf(a,b); { auto rr=__builtin_amdgcn_permlane32_swap(__float_as_uint(rm),__float_as_uint(rm),false,false); rm=__builtin_fmaxf(__uint_as_float(rr[0]),__uint_as_float(rr[1])); } \
      resc=false; const bool live_=(rm>NEG); \
      if(__any((rm>(float)THRL)||(live_&&!seen&&(rm<-64.f)))){ const float dl=seen?__builtin_fmaxf(rm,0.f):(live_?rm:0.f); mhat+=dl; \
        _Pragma("unroll") for(int r=0;r<16;++r){C0[r]-=dl;C1[r]-=dl;} \
        const float f=seen?__builtin_amdgcn_exp2f(-dl):1.f; l_reg*=f; if(hi==0)wsf[r32]=f; resc=true; } \
      seen=seen||live_; } \
    SBAR(); \
    GAPB(o[0]=__builtin_amdgcn_mfma_f32_32x32x16_bf16(PAF(0),VFR(0),o[0],0,0,0), C0,0); \
    GAPB(o[1]=__builtin_amdgcn_mfma_f32_32x32x16_bf16(PAF(0),VFR(4),o[1],0,0,0), C0,4); \
    KRD(GL,0); GAPB(o[0]=__builtin_amdgcn_mfma_f32_32x32x16_bf16(PAF(1),VFR(1),o[0],0,0,0), C0,8); \
    KRD(GL,1); GAPB(o[1]=__builtin_amdgcn_mfma_f32_32x32x16_bf16(PAF(1),VFR(5),o[1],0,0,0), C0,12); \
    KRD(GL,2); GAPB(o[0]=__builtin_amdgcn_mfma_f32_32x32x16_bf16(PAF(2),VFR(2),o[0],0,0,0), C1,0); \
    KRD(GL,3); GAPB(o[1]=__builtin_amdgcn_mfma_f32_32x32x16_bf16(PAF(2),VFR(6),o[1],0,0,0), C1,4); \
    GAPB(o[0]=__builtin_amdgcn_mfma_f32_32x32x16_bf16(PAF(3),VFR(3),o[0],0,0,0), C1,8); \
    GAPB(o[1]=__builtin_amdgcn_mfma_f32_32x32x16_bf16(PAF(3),VFR(7),o[1],0,0,0), C1,12); \
    }while(0)
  int t=1;
  for(;t+5<NT;t+=2){
    STEP(pB0,pB1,pA0,pA1,t,true,true,true);     WAIT_BAR(2); RESC(); ROT();
    STEP(pA0,pA1,pB0,pB1,t+1,true,true,true);   WAIT_BAR(2); RESC(); ROT();
  }
  #define ENDW(tt) do{ if((tt)+3<NT){WAIT_BAR(2);} else if((tt)+2<NT){WAIT_BAR(1);} else {WAIT_BAR(0);} }while(0)
  for(;t+1<NT;t+=2){
    STEP(pB0,pB1,pA0,pA1,t,(t+3<NT),(t+1<NT),(t+1<NT));       ENDW(t);   RESC(); ROT();
    STEP(pA0,pA1,pB0,pB1,t+1,(t+4<NT),(t+2<NT),(t+2<NT));     ENDW(t+1); RESC(); ROT();
  }
  STEP(pB0,pB1,pA0,pA1,NT-1,false,false,false); RESC();
  { float sacc=pB0[0]+pB0[1]; _Pragma("unroll") for(int r=2;r<16;++r)sacc+=pB0[r]; _Pragma("unroll") for(int r=0;r<16;++r)sacc+=pB1[r]; l_reg+=sacc;
    pw0=(u32x4){PKW(pB0,0),PKW(pB0,2),PKW(pB0,4),PKW(pB0,6)};pw1=(u32x4){PKW(pB0,8),PKW(pB0,10),PKW(pB0,12),PKW(pB0,14)};pw2=(u32x4){PKW(pB1,0),PKW(pB1,2),PKW(pB1,4),PKW(pB1,6)};pw3=(u32x4){PKW(pB1,8),PKW(pB1,10),PKW(pB1,12),PKW(pB1,14)};
    SBAR(); pv(o,vb0+sl_cur,PAF(0),PAF(1),PAF(2),PAF(3)); }
  #undef PKW
  #undef PAF
  #undef VFR
  #undef PIN
  #undef MX3
  #undef GAPA
  #undef GAPB
  #undef EX
  #undef VRD
  #undef KRD
  #undef STEP
  #undef ENDW
  {auto rr=__builtin_amdgcn_permlane32_swap(__float_as_uint(l_reg),__float_as_uint(l_reg),false,false);l_reg=__uint_as_float(rr[0])+__uint_as_float(rr[1]);}
  if(hi==0)wsf[32+r32]=l_reg;asm volatile("s_waitcnt lgkmcnt(0)":::"memory");
  float rli[16];
  #pragma unroll
  for(int r=0;r<16;++r)rli[r]=__builtin_amdgcn_rcpf(wsf[32+crow(r,hi)]);
  bf16*Ow=O+(rowbase+q0+wid*QBLK)*DM+h*D;
  { bf16*stg=(bf16*)(shm+LDS_OST)+wid*2048;
    #pragma unroll
    for(int r=0;r<16;++r){const int orow=crow(r,hi);
      #pragma unroll
      for(int d0=0;d0<2;++d0)stg[orow*64+d0*32+r32]=__float2bfloat16(o[d0][r]*rli[r]);}
    asm volatile("s_waitcnt lgkmcnt(0)":::"memory");
    #pragma unroll
    for(int i=0;i<4;++i){const int row=i*8+(lane>>3),ch=lane&7; const u32x4 v=*(const u32x4*)(stg+row*64+ch*8); ATTN_STORE16(Ow+(long)row*DM+ch*8,v);} }
  asm volatile("s_waitcnt lgkmcnt(0)\n\ts_barrier":::"memory");
  #undef DMA_K
  #undef DMA_V
  #undef CMASK
  #undef MASKALIBI
  #undef MLOAD
  #undef MSEL
  #undef START
  #undef RESC
  #undef ROT
}
constexpr int ATTN_LDS_BYTES=LDS_BYTES;
struct AttnTensors { const bf16* Q; const bf16* K; const bf16* V; bf16* O; const unsigned long long* MASK; };
struct AttnUnit { int bh; int qb; };
struct StaticOrder {
  int vcu;
  __device__ __forceinline__ explicit StaticOrder(int grid,int block):vcu((block%8)*(grid/8)+block/8){}
  __device__ __forceinline__ bool next(int i,AttnUnit&u)const{ if(i>=2)return false; const int s=vcu&15; u.bh=vcu>>4; u.qb=(i==0)?s:31-s; return true; }
  __device__ __forceinline__ void a_ready(const AttnUnit&)const{}
  __device__ __forceinline__ void done(const AttnUnit&)const{}
};
template<class Sched,int THRL=8> __device__ __forceinline__ void attn_phase(char*lds,const AttnTensors&T,const Sched&S){
  AttnUnit u;
  for(int i=0;S.next(i,u);++i){ S.a_ready(u); attn_unit<THRL>(u.bh/NHEAD,u.bh%NHEAD,u.qb,T.Q,T.K,T.V,T.O,T.MASK,lds); S.done(u); }
}
#undef SBAR
#undef WAIT_BAR
}
namespace idx_body {
using bf16x8 = __attribute__((ext_vector_type(8))) short;
using f32x16 = __attribute__((ext_vector_type(16))) float;
using u32x4 = __attribute__((ext_vector_type(4))) unsigned;
typedef __attribute__((address_space(3))) unsigned lds_u32;
constexpr int SEQ = 8192, CAP = 896, TOPK = 256, HW = CAP - 128, SLOTB = 8192, NSLOT = 4;
constexpr int LDS_RING = 0, LDS_LIST = NSLOT * SLOTB, LDS_FLAG = LDS_LIST + 32 * CAP * 4, LDS_BYTES = LDS_FLAG + 64;
__device__ __forceinline__ unsigned ord_key(float s) { const unsigned b = __builtin_bit_cast(unsigned, s); return b ^ ((unsigned)((int)b >> 31) | 0x80000000u); }
__device__ __forceinline__ float ord_floor_to_float(unsigned T) {
    const unsigned o = T & 0xFFFFE000u; if (o <= 0x007FFFFFu) return -INFINITY;
    const unsigned b = (o & 0x80000000u) ? (o ^ 0x80000000u) : ~o; return __builtin_bit_cast(float, b);
}
__device__ __forceinline__ int wave_select(lds_u32* lst, int cnt, int target_hi, int lane, unsigned* Tout) {
    unsigned e[CAP / 64];
#pragma unroll
    for (int j = 0; j < CAP / 64; ++j) e[j] = (j * 64 + lane < cnt) ? lst[j * 64 + lane] : 0u;
    unsigned T = 0u; int cT = cnt;
    for (int bit = 31; bit >= 0 && cT > target_hi; --bit) {
        const unsigned cand = T | (1u << bit); int c = 0;
#pragma unroll
        for (int j = 0; j < CAP / 64; ++j) if (j * 64 < cnt) c += __builtin_popcountll(__ballot(e[j] >= cand));
        if (c >= TOPK) { T = cand; cT = c; }
    }
    asm volatile("s_waitcnt lgkmcnt(0)" ::: "memory");
    int base = 0;
#pragma unroll
    for (int j = 0; j < CAP / 64; ++j) { const bool k = (e[j] >= T) && (e[j] != 0u); const unsigned long long m = __ballot(k);
        if (k) lst[base + __builtin_popcountll(m & ((1ull << lane) - 1ull))] = e[j];
        base += __builtin_popcountll(m); }
    *Tout = T; return base;
}
#define RELU(x) __builtin_bit_cast(float, max(__builtin_bit_cast(int, (float)(x)), 0))
__device__ __forceinline__ void glds16(const void* gsrc, unsigned lds_dst) { unsigned keep;
    asm volatile("s_mov_b32 %0, m0\n\ts_mov_b32 m0, %2\n\ts_nop 0\n\tglobal_load_lds_dwordx4 %1, off\n\ts_mov_b32 m0, %0" : "=&s"(keep) : "v"(gsrc), "s"(lds_dst) : "memory"); }

__device__ __forceinline__ void idx_unit(int b, int qb, const unsigned short* QI, const unsigned short* KI, const float* WI, unsigned* MASK, char* shm, unsigned* dbg = nullptr, bool dry = false) {
    const int tid = threadIdx.x, lane = tid & 63, r32 = lane & 31, hi = lane >> 5; const int wid = __builtin_amdgcn_readfirstlane(tid >> 6);
    const long rowbase = (long)b * SEQ; const int q0 = qb * 32;
    const unsigned lds0 = (unsigned)(uintptr_t)shm;
    lds_u32* lists = (lds_u32*)(__attribute__((address_space(3))) char*)(shm + LDS_LIST);
    lds_u32* flag = (lds_u32*)(__attribute__((address_space(3))) char*)(shm + LDS_FLAG);
    bf16x8 aq[4];
    { const unsigned short* qp = QI + (rowbase + q0 + 4 * wid + (r32 >> 3)) * 512 + (r32 & 7) * 64 + hi * 8;
#pragma unroll
      for (int ks = 0; ks < 4; ++ks) aq[ks] = *(const bf16x8*)(qp + ks * 16); }
    float wv[16];
#pragma unroll
    for (int g = 0; g < 4; ++g)
#pragma unroll
        for (int i = 0; i < 4; ++i) wv[4 * g + i] = WI[(rowbase + q0 + 4 * wid + g) * 8 + 4 * hi + i];
    const int NT = ((q0 + 31) >> 6) + 1;
    const unsigned short* ksrc = KI + (rowbase + lane) * 64 + wid * 8;
    const unsigned kdst = lds0 + LDS_RING + wid * 1024;
    int cnt0 = 0, cnt1 = 0, cnt2 = 0, cnt3 = 0;
    float tf0 = -INFINITY, tf1 = -INFINITY, tf2 = -INFINITY, tf3 = -INFINITY;
    const int qposA = q0 + 4 * wid + (hi ? 2 : 0), qposB = qposA + 1;
    lds_u32* listA = lists + (4 * wid + (hi ? 2 : 0)) * CAP; lds_u32* listB = listA + CAP;
    if (tid == 0) { flag[0] = 0u; flag[1] = 0u; }
    asm volatile("" : "+v"(aq[0]), "+v"(aq[1]), "+v"(aq[2]), "+v"(aq[3]));
#pragma unroll
    for (int i = 0; i < 16; ++i) asm volatile("" : "+v"(wv[i]));
    glds16(ksrc, (unsigned)__builtin_amdgcn_readfirstlane(kdst));
    if (NT > 1) glds16(ksrc + (long)1 * 64 * 64, (unsigned)__builtin_amdgcn_readfirstlane(kdst + 1 * SLOTB));
    if (NT > 2) glds16(ksrc + (long)2 * 64 * 64, (unsigned)__builtin_amdgcn_readfirstlane(kdst + 2 * SLOTB));
    bool need = false;
#define IDX_WAITBAR(u) do { if ((u) + 2 < NT) asm volatile("s_waitcnt vmcnt(2) lgkmcnt(0)\n\ts_barrier" ::: "memory"); \
        else if ((u) + 1 < NT) asm volatile("s_waitcnt vmcnt(1) lgkmcnt(0)\n\ts_barrier" ::: "memory"); else asm volatile("s_waitcnt vmcnt(0) lgkmcnt(0)\n\ts_barrier" ::: "memory"); } while (0)
#define IDX_TILE_MFMA(u, A0, A1) do { const __attribute__((address_space(3))) char* slot_ = (const __attribute__((address_space(3))) char*)(shm + LDS_RING + ((u) & (NSLOT - 1)) * SLOTB) + hi * 1024 + r32 * 16; bf16x8 kb_[2][4]; \
        _Pragma("unroll") for (int p_ = 0; p_ < 2; ++p_) _Pragma("unroll") for (int ks_ = 0; ks_ < 4; ++ks_) kb_[p_][ks_] = *(const __attribute__((address_space(3))) bf16x8*)(slot_ + ks_ * 2048 + p_ * 512); \
        A0 = f32x16{}; A1 = f32x16{}; \
        _Pragma("unroll") for (int ks_ = 0; ks_ < 4; ++ks_) { A0 = __builtin_amdgcn_mfma_f32_32x32x16_bf16(aq[ks_], kb_[0][ks_], A0, 0, 0, 0); A1 = __builtin_amdgcn_mfma_f32_32x32x16_bf16(aq[ks_], kb_[1][ks_], A1, 0, 0, 0); } } while (0)
    f32x16 accs[2], accn[2];
    IDX_WAITBAR(0);
    if (3 < NT) glds16(ksrc + (long)3 * 64 * 64, (unsigned)__builtin_amdgcn_readfirstlane(kdst + 3 * SLOTB));
    IDX_TILE_MFMA(0, accs[0], accs[1]);
    for (int t = 0; t < NT; ++t) {
        if (t + 1 < NT) {
            IDX_WAITBAR(t + 1);
            if (t + 4 < NT) glds16(ksrc + (long)(t + 4) * 64 * 64, (unsigned)__builtin_amdgcn_readfirstlane(kdst + ((t + 4) & (NSLOT - 1)) * SLOTB));
            IDX_TILE_MFMA(t + 1, accn[0], accn[1]);
        } else { asm volatile("s_waitcnt lgkmcnt(0)\n\ts_barrier" ::: "memory"); }
        if (t > 0) {
            const bool go = need || (flag[(t - 1) & 1] == (unsigned)t);
            if (go) {
                for (int g = 0; g < 4; ++g) { const int cg = (g == 0) ? cnt0 : (g == 1) ? cnt1 : (g == 2) ? cnt2 : cnt3;
                    if (cg > 384) { unsigned T; const int nc = wave_select(lists + (4 * wid + g) * CAP, cg, 320, lane, &T); const float tf = ord_floor_to_float(T);
                        if (g == 0) { cnt0 = nc; tf0 = tf; } else if (g == 1) { cnt1 = nc; tf1 = tf; } else if (g == 2) { cnt2 = nc; tf2 = tf; } else { cnt3 = nc; tf3 = tf; } } }
            }
        }
#if defined(IDX_NOFILTER)
        const float tauA = -INFINITY, tauB = -INFINITY;
#else
        const float tauA = dry ? INFINITY : (hi ? tf2 : tf0), tauB = dry ? INFINITY : (hi ? tf3 : tf1);
#endif
#pragma unroll
        for (int p = 0; p < 2; ++p) {
            const f32x16 acc = accs[p];
            float P[4];
#pragma unroll
            for (int g = 0; g < 4; ++g) { float s = wv[4 * g] * RELU(acc[4 * g]);
#pragma unroll
                for (int i = 1; i < 4; ++i) s = __builtin_fmaf(wv[4 * g + i], RELU(acc[4 * g + i]), s);
                P[g] = s; }
#if defined(IDX_SHFL)
            const float F0 = P[0] + __shfl_xor(P[0], 32), F1 = P[1] + __shfl_xor(P[1], 32), F2 = P[2] + __shfl_xor(P[2], 32), F3 = P[3] + __shfl_xor(P[3], 32);
            const float SA = hi ? F2 : F0, SB = hi ? F3 : F1;
#else
            const auto rA = __builtin_amdgcn_permlane32_swap(__builtin_bit_cast(unsigned, P[0]), __builtin_bit_cast(unsigned, P[2]), false, false);
            const auto rB = __builtin_amdgcn_permlane32_swap(__builtin_bit_cast(unsigned, P[1]), __builtin_bit_cast(unsigned, P[3]), false, false);
            const unsigned a0_ = rA[0], a1_ = rA[1], b0_ = rB[0], b1_ = rB[1];
            const float SA = __uint_as_float(a0_) + __uint_as_float(a1_);
            const float SB = __uint_as_float(b0_) + __uint_as_float(b1_);
#endif
            const int kk = 64 * t + 32 * p + r32;
#if defined(IDX_DBG)
            if ((IDX_DBG & 16) && t == (NT > 3 ? 3 : 0)) {
                const size_t qa = (size_t)(rowbase + qposA), kr = (size_t)(rowbase + kk); float ea = 0.f, eb = 0.f;
                for (int j = 0; j < 8; ++j) { float da = 0.f, db = 0.f;
                    for (int k = 0; k < 64; ++k) { const float kv = __builtin_bit_cast(float, (unsigned)KI[kr * 64 + k] << 16);
                        da = __builtin_fmaf(__builtin_bit_cast(float, (unsigned)QI[qa * 512 + j * 64 + k] << 16), kv, da); db = __builtin_fmaf(__builtin_bit_cast(float, (unsigned)QI[(qa + 1) * 512 + j * 64 + k] << 16), kv, db); }
                    ea = __builtin_fmaf(WI[qa * 8 + j], __builtin_fmaxf(da, 0.f), ea); eb = __builtin_fmaf(WI[(qa + 1) * 8 + j], __builtin_fmaxf(db, 0.f), eb); }
                const bool bad = !(fabsf(SA - ea) <= 1e-3f * fabsf(ea) + 1e-2f) || !(fabsf(SB - eb) <= 1e-3f * fabsf(eb) + 1e-2f);
                if (bad) __hip_atomic_store(dbg, 1u, __ATOMIC_RELAXED, __HIP_MEMORY_SCOPE_AGENT); }
#endif
            const bool pa = (SA >= tauA) && (kk <= qposA), pb = (SB >= tauB) && (kk <= qposB);
            const unsigned long long ma = __ballot(pa), mb = __ballot(pb);
            if (ma | mb) {
                const unsigned below = (1u << r32) - 1u;
                const unsigned ha = hi ? (unsigned)(ma >> 32) : (unsigned)ma, hb = hi ? (unsigned)(mb >> 32) : (unsigned)mb;
                const int posA = (hi ? cnt2 : cnt0) + __builtin_popcount(ha & below), posB = (hi ? cnt3 : cnt1) + __builtin_popcount(hb & below);
                const unsigned kidx = (unsigned)(8191 - kk);
                if (pa && posA < CAP) listA[posA] = (ord_key(SA) & 0xFFFFE000u) | kidx;
                if (pb && posB < CAP) listB[posB] = (ord_key(SB) & 0xFFFFE000u) | kidx;
                cnt0 += __builtin_popcount((unsigned)ma); cnt2 += __builtin_popcount((unsigned)(ma >> 32));
                cnt1 += __builtin_popcount((unsigned)mb); cnt3 += __builtin_popcount((unsigned)(mb >> 32));
            }
        }
        const int mx = max(max(cnt0, cnt1), max(cnt2, cnt3));
        need = mx > HW;
        if (need && lane == 0) flag[t & 1] = (unsigned)(t + 1);
        accs[0] = accn[0]; accs[1] = accn[1];
    }
#undef IDX_WAITBAR
#undef IDX_TILE_MFMA
    if (dry) { asm volatile("s_waitcnt lgkmcnt(0)\n\ts_barrier" ::: "memory"); return; }
    asm volatile("s_waitcnt lgkmcnt(0)" ::: "memory");
    for (int g = 0; g < 4; ++g) { const int cg = (g == 0) ? cnt0 : (g == 1) ? cnt1 : (g == 2) ? cnt2 : cnt3;
        if (cg > TOPK) { unsigned T; const int nc = wave_select(lists + (4 * wid + g) * CAP, cg, TOPK, lane, &T);
            if (g == 0) cnt0 = nc; else if (g == 1) cnt1 = nc; else if (g == 2) cnt2 = nc; else cnt3 = nc; } }
    asm volatile("s_waitcnt lgkmcnt(0)" ::: "memory");
#if defined(IDX_DBG)
    { const int w0 = min(TOPK, q0 + 4 * wid + 0 + 1), w1 = min(TOPK, q0 + 4 * wid + 1 + 1), w2 = min(TOPK, q0 + 4 * wid + 2 + 1), w3 = min(TOPK, q0 + 4 * wid + 3 + 1);
      if ((IDX_DBG & 4) && (cnt0 > w0 || cnt1 > w1 || cnt2 > w2 || cnt3 > w3) && lane == 0) __hip_atomic_store(dbg, 1u, __ATOMIC_RELAXED, __HIP_MEMORY_SCOPE_AGENT);
      if ((IDX_DBG & 8) && (cnt0 < w0 || cnt1 < w1 || cnt2 < w2 || cnt3 < w3) && lane == 0) __hip_atomic_store(dbg, 1u, __ATOMIC_RELAXED, __HIP_MEMORY_SCOPE_AGENT);
      if ((IDX_DBG & 1) && (cnt0 != w0 || cnt1 != w1 || cnt2 != w2 || cnt3 != w3) && lane == 0) __hip_atomic_store(dbg, 1u, __ATOMIC_RELAXED, __HIP_MEMORY_SCOPE_AGENT); }
#endif
    unsigned ent[4][4];
#pragma unroll
    for (int g = 0; g < 4; ++g) { const int c = (g == 0) ? cnt0 : (g == 1) ? cnt1 : (g == 2) ? cnt2 : cnt3; const int cc = c < TOPK ? c : TOPK;
#pragma unroll
        for (int j = 0; j < 4; ++j) ent[g][j] = (j * 64 + lane < cc) ? lists[(4 * wid + g) * CAP + j * 64 + lane] : 0xFFFFFFFFu; }
    asm volatile("s_waitcnt lgkmcnt(0)" ::: "memory");
    __syncthreads();
    lds_u32* img = lists;
#pragma unroll
    for (int i = 0; i < 4; ++i) *(__attribute__((address_space(3))) u32x4*)(img + (i * 512 + tid) * 4) = (u32x4){0u, 0u, 0u, 0u};
    asm volatile("s_waitcnt lgkmcnt(0)" ::: "memory");
    __syncthreads();
#pragma unroll
    for (int g = 0; g < 4; ++g)
#pragma unroll
        for (int j = 0; j < 4; ++j) if (ent[g][j] != 0xFFFFFFFFu) {
            const int kk = 8191 - (int)(ent[g][j] & 0x1FFFu); const int tt = kk >> 6, kl = kk & 63;
            __hip_atomic_fetch_or(img + tt * 64 + (4 * wid + g) * 2 + (kl >> 5), 1u << (kl & 31), __ATOMIC_RELAXED, __HIP_MEMORY_SCOPE_WORKGROUP); }
    asm volatile("s_waitcnt lgkmcnt(0)" ::: "memory");
    __syncthreads();
#if defined(IDX_DBG)
    if (IDX_DBG & 2) {
        const int row = tid & 31, part = tid >> 5; int pc = 0;
        for (int tt = part * 8; tt < part * 8 + 8; ++tt) pc += __builtin_popcount(img[tt * 64 + row * 2]) + __builtin_popcount(img[tt * 64 + row * 2 + 1]);
        lds_u32* accp = (lds_u32*)(__attribute__((address_space(3))) char*)(shm + LDS_RING);
        if (tid < 32) accp[tid] = 0u;
        __syncthreads();
        __hip_atomic_fetch_add(accp + row, (unsigned)pc, __ATOMIC_RELAXED, __HIP_MEMORY_SCOPE_WORKGROUP);
        __syncthreads();
        if (tid < 32) { const int want = min(TOPK, q0 + tid + 1); if ((int)accp[tid] != want) __hip_atomic_store(dbg, 1u, __ATOMIC_RELAXED, __HIP_MEMORY_SCOPE_AGENT); }
        __syncthreads(); }
#endif
    { unsigned* dst = MASK + ((size_t)(b * (SEQ / 32) + qb) * (SEQ / 64)) * 64;
#pragma unroll
      for (int i = 0; i < 4; ++i) { const u32x4 v = *(const __attribute__((address_space(3))) u32x4*)(img + (i * 512 + tid) * 4); *(u32x4*)(dst + (i * 512 + tid) * 4) = v; } }
    asm volatile("s_waitcnt lgkmcnt(0)" ::: "memory");
    __syncthreads();
}
}

#ifndef ATT_THRL
#define ATT_THRL 8
#endif
#ifndef CNT_THRESH
#define CNT_THRESH 64
#endif
#ifndef CHECK14_LAUNCH
#define CHECK14_LAUNCH 0
#endif
#ifndef CHK14_ROW0
#define CHK14_ROW0 4096
#endif
#ifndef CHK14_BUF
#define CHK14_BUF SGA
#define CHK14_COL 3144
#endif
#ifndef P2_ALIGN
#define P2_ALIGN true
#endif
#ifndef P2_SP2
#define P2_SP2 true
#endif
#ifndef CHK19_ROW0
#define CHK19_ROW0 0
#define CHK19_NROW 16384
#endif
#ifndef CHK19_COL0
#define CHK19_COL0 0
#define CHK19_NCOL 1024
#endif
#ifndef CHK19_REL
#define CHK19_REL 2e-2f
#define CHK19_ABS 1e-2f
#endif
#ifndef IDX_REPS
#define IDX_REPS 1
#endif
constexpr int NWAVES = 8;
constexpr int BATCH = 2, T = 8192, D = 1024, NH = 8, HD = 64, AW = 512, CC = 512, CWID = 31, DFF = 2816, NMOD = 6;
constexpr int M = BATCH * T;
constexpr int NIN = 5192, NIN_PAD = 5376;
constexpr int NFF1 = 2 * DFF;
constexpr float EPS = 1e-6f;
constexpr size_t MiB = 1u << 20;
constexpr size_t WS_CTL = 0, CTL_ZERO_BYTES = 1 * MiB;
constexpr size_t WS_WIN = 1 * MiB;
constexpr size_t WS_WAP = 12 * MiB;
constexpr size_t WS_WCP = 13 * MiB;
constexpr size_t WS_WOUT = 14 * MiB;
constexpr size_t WS_WFF1 = 16 * MiB;
constexpr size_t WS_WFF2 = 28 * MiB;
constexpr size_t WS_MOD = 34 * MiB;
constexpr size_t WS_MODP = 34 * MiB + 65536;
constexpr size_t WS_KI = 35 * MiB;
constexpr size_t WS_WI = 37 * MiB;
constexpr size_t WS_XN = 38 * MiB;
constexpr size_t WS_Q = 70 * MiB;
constexpr size_t WS_K = 86 * MiB;
constexpr size_t WS_V = 102 * MiB;
constexpr size_t WS_QI = 118 * MiB;
constexpr size_t WS_Z = 134 * MiB;
constexpr size_t WS_SGA = 150 * MiB;
constexpr size_t WS_SGB = 182 * MiB;
constexpr size_t WS_MASK = 214 * MiB;
constexpr size_t WS_CO = 230 * MiB;
constexpr size_t WS_MERGED = WS_XN;
constexpr size_t WS_XN2 = WS_Q;
constexpr size_t WS_H = WS_V;
constexpr size_t WS_END = 256 * MiB;
static_assert(WS_H + (size_t)M * DFF * 2 <= WS_MASK + 16 * MiB && WS_CO + (size_t)M * 512 * 2 <= WS_END, "d_ws map");
constexpr int CW_TMO = 0, CW_CODE = 1, CW_CHK = 2;
constexpr int CW_BAR = 4096;
constexpr int RING_OFF = 0, RING_BYTES = 147456;
constexpr int LDSCTL_OFF = RING_BYTES + 256, MISC_OFF = LDSCTL_OFF + 320;
constexpr int LDS_BYTES = LDSCTL_OFF + 1024;
static_assert(idx_body::LDS_BYTES <= LDSCTL_OFF && MISC_OFF + 128 <= LDS_BYTES && LDS_BYTES <= 163840, "LDS map");

#define GAS __attribute__((address_space(1)))
#define LAS __attribute__((address_space(3)))
typedef unsigned short bf16;
typedef unsigned v4u __attribute__((ext_vector_type(4)));
typedef float f32x4 __attribute__((ext_vector_type(4)));
typedef short bf16x8 __attribute__((ext_vector_type(8)));
typedef GAS unsigned gu32;
typedef GAS unsigned long long gu64;
#define RLX_AGENT __ATOMIC_RELAXED, __HIP_MEMORY_SCOPE_AGENT
#define LDS_WAIT() asm volatile("s_waitcnt lgkmcnt(0)" ::: "memory")
#define VM_WAIT() asm volatile("s_waitcnt vmcnt(0)" ::: "memory")
__device__ __forceinline__ unsigned long long rt() { return __builtin_amdgcn_s_memrealtime(); }
__device__ __forceinline__ unsigned f2bf(float f) { unsigned u = __builtin_bit_cast(unsigned, f); return (u + 0x7fffu + ((u >> 16) & 1u)) >> 16; }
__device__ __forceinline__ unsigned pk2(float lo, float hi) { return f2bf(lo) | (f2bf(hi) << 16); }

#define XB_TMO      128
#define XB_XCNT(j)  (256  + 64 * (j))
#define XB_XSUB(j)  (1280 + 64 * (j))
#define XB_XGEN(j)  (2304 + 64 * (j))
#define XB_TOP      3328
#define XB_TOPGEN   3392
#define XCD_BAR_WORDS 3456
#define XB_SPIN_CAP (1u << 18)

__device__ __forceinline__ unsigned xb_ld(unsigned* p)              { return __hip_atomic_load(p, __ATOMIC_RELAXED, __HIP_MEMORY_SCOPE_AGENT); }
__device__ __forceinline__ unsigned xb_add(unsigned* p, unsigned v) { return __hip_atomic_fetch_add(p, v, __ATOMIC_RELAXED, __HIP_MEMORY_SCOPE_AGENT); }
__device__ __forceinline__ unsigned xb_xcc_id() { return (unsigned)__builtin_amdgcn_s_getreg((3 << 11) | 20) & 0xFu; }
#define XB_SPIN(cond, bar) do { unsigned _sp = 0; while (cond) { __builtin_amdgcn_s_sleep(1); \
    if ((++_sp & 255u) == 0u) { if (xb_ld(&(bar)[XB_TMO])) break; if (_sp > XB_SPIN_CAP) { atomicAdd(&(bar)[XB_TMO], 1u); break; } } } } while (0)

#if defined(SYS_FENCE)
#define BAR_FENCE_REL() __builtin_amdgcn_fence(__ATOMIC_RELEASE, "")
#define BAR_FENCE_ACQ() __builtin_amdgcn_fence(__ATOMIC_ACQUIRE, "")
#else
#define BAR_FENCE_REL() __builtin_amdgcn_fence(__ATOMIC_RELEASE, "agent")
#define BAR_FENCE_ACQ() __builtin_amdgcn_fence(__ATOMIC_ACQUIRE, "agent")
#endif
struct XcdBarrier {
    unsigned* bar; unsigned x;
    volatile LAS unsigned* st;
};

__device__ __forceinline__ XcdBarrier xcd_barrier_post(unsigned* bar, volatile LAS unsigned* st) {
    XcdBarrier b; b.bar = bar; b.x = xb_xcc_id(); b.st = st;
    if (threadIdx.x == 0) (void)xb_add(&bar[XB_XCNT(b.x)], 1u);
    return b;
}
__device__ __forceinline__ void xcd_barrier_complete(unsigned* bar, unsigned x, unsigned& nloc, unsigned& nx) {
    const unsigned G = gridDim.x * gridDim.y * gridDim.z;
    unsigned sum, cnt, mine, sp = 0u;
    for (;;) {
        sum = 0u; cnt = 0u; mine = 0u;
#pragma unroll
        for (unsigned j = 0; j < 16; ++j) { const unsigned c = xb_ld(&bar[XB_XCNT(j)]); sum += c; cnt += (c > 0u) ? 1u : 0u; mine = (j == x) ? c : mine; }
        if (sum == G) break;
        __builtin_amdgcn_s_sleep(1);
        if ((++sp & 255u) == 0u) { if (xb_ld(&bar[XB_TMO])) break; if (sp > XB_SPIN_CAP) { atomicAdd(&bar[XB_TMO], 1u); break; } }
    }
    nloc = mine > 0u ? mine : 1u; nx = cnt > 0u ? cnt : 1u;
}

__device__ __forceinline__ void xcd_barrier(const XcdBarrier& b) {
#if defined(BAR_DELAY)
    asm volatile("s_waitcnt vmcnt(0)" ::: "memory"); { const unsigned long long t0_ = __builtin_amdgcn_s_memrealtime(); while (__builtin_amdgcn_s_memrealtime() - t0_ < (unsigned long long)BAR_DELAY) __builtin_amdgcn_s_sleep(8); }
#endif
#if defined(STRONG_FENCE)
    __threadfence();
#endif
    asm volatile("s_waitcnt vmcnt(0)" ::: "memory");
    __syncthreads();
    if (threadIdx.x == 0) {
        unsigned* bar = b.bar;
        __builtin_amdgcn_s_waitcnt(0);
        unsigned nloc = b.st[0], nx = b.st[1];
        if (nloc == 0u) { xcd_barrier_complete(bar, b.x, nloc, nx); b.st[0] = nloc; b.st[1] = nx; }
        const unsigned old = xb_add(&bar[XB_XSUB(b.x)], 1u);
        const unsigned gen = old / nloc;
        if (old + 1u == (gen + 1u) * nloc) {
            BAR_FENCE_REL();
            asm volatile("s_waitcnt vmcnt(0)" ::: "memory");
            const unsigned og = xb_add(&bar[XB_TOP], 1u);
            const unsigned tg = og / nx;
            if (og + 1u == (tg + 1u) * nx) xb_add(&bar[XB_TOPGEN], 1u);
            else XB_SPIN(xb_ld(&bar[XB_TOPGEN]) == tg, bar);
            BAR_FENCE_ACQ();
            xb_add(&bar[XB_XGEN(b.x)], 1u);
            asm volatile("s_waitcnt vmcnt(0)" ::: "memory");
        } else {
            XB_SPIN(xb_ld(&bar[XB_XGEN(b.x)]) == gen, bar);
            BAR_FENCE_ACQ();
            asm volatile("s_waitcnt vmcnt(0)" ::: "memory");
        }
    }
    __syncthreads();
#if defined(STRONG_FENCE)
    __threadfence();
#endif
}
__device__ __forceinline__ float bflo(unsigned w) { return __builtin_bit_cast(float, w << 16); }
__device__ __forceinline__ float bfhi(unsigned w) { return __builtin_bit_cast(float, w & 0xffff0000u); }

struct Frame {
    LAS unsigned char* lds;
    volatile LAS unsigned* MISC;
    gu32* ctl;
    int tid, lane, wave;
    int vcu, G;
};
__device__ __forceinline__ float wave_sum(float v) {
#pragma unroll
    for (int o = 1; o < 64; o <<= 1) v += __shfl_xor(v, o);
    return v;
}
__device__ __forceinline__ float sigmf(float x) { return __builtin_amdgcn_rcpf(1.0f + __builtin_amdgcn_exp2f(-1.4426950408889634f * x)); }
__device__ __forceinline__ void p0_transpose_item(const float* W, int K, int N, bf16* WT, int kb, int dr0, int sc0, int nvalid, LAS float* scr, int lane) {
    const int k0 = 64 * kb; const int cl = lane & 31; const bool ok = (sc0 >= 0) && (cl < nvalid);
#pragma unroll 8
    for (int i = 0; i < 32; ++i) { const int kk = 2 * i + (lane >> 5); scr[kk * 33 + cl] = ok ? W[(size_t)(k0 + kk) * N + sc0 + cl] : 0.f; }
    LDS_WAIT(); asm volatile("" ::: "memory");
    const int c = lane & 7;
#pragma unroll
    for (int j = 0; j < 4; ++j) { const int n = (lane >> 3) + 8 * j; const LAS float* s = scr + (8 * c) * 33 + n;
        v4u o; o.x = pk2(s[0 * 33], s[1 * 33]); o.y = pk2(s[2 * 33], s[3 * 33]); o.z = pk2(s[4 * 33], s[5 * 33]); o.w = pk2(s[6 * 33], s[7 * 33]);
        *(GAS v4u*)(WT + (size_t)(dr0 + n) * K + k0 + 8 * c) = o; }
    LDS_WAIT(); asm volatile("" ::: "memory");
}
__device__ __forceinline__ void win_map(int dr0, int& sc0, int& nv) {
    nv = 32;
    if (dr0 < 2048) sc0 = dr0;
    else if (dr0 < 3072) { const int j = (dr0 - 2048) >> 8, w = (dr0 - 2048) & 255;
        sc0 = (w < 128) ? (2120 + 128 * j + w) : (2632 + 128 * j + (w - 128)); }
    else if (dr0 < 4096) sc0 = 3144 + (dr0 - 3072);
    else if (dr0 < 5120) sc0 = 4168 + (dr0 - 4096);
    else if (dr0 < 5184) sc0 = 2048 + (dr0 - 5120);
    else if (dr0 == 5184) { sc0 = 2112; nv = 8; }
    else sc0 = -1;
}
__device__ __forceinline__ void ff1_map(int dr0, int& sc0, int& nv) {
    nv = 32; const int j = dr0 >> 8, w = dr0 & 255; sc0 = (w < 128) ? (128 * j + w) : (DFF + 128 * j + (w - 128));
}
__device__ __forceinline__ void rms_row_to_bf16(const float* xrow, bf16* orow, const LAS float* A, const LAS float* Bv, int lane) {
    const GAS f32x4* xr = (const GAS f32x4*)xrow + lane;
    f32x4 v[4]; float s2 = 0.f;
#pragma unroll
    for (int j = 0; j < 4; ++j) { v[j] = xr[64 * j]; s2 += (v[j].x * v[j].x + v[j].y * v[j].y) + (v[j].z * v[j].z + v[j].w * v[j].w); }
    const float rstd = 1.f / sqrtf(wave_sum(s2) * (1.f / D) + EPS);
    GAS unsigned long long* o8 = (GAS unsigned long long*)orow + lane;
#pragma unroll
    for (int j = 0; j < 4; ++j) { const f32x4 a = *(const LAS f32x4*)(A + 4 * lane + 256 * j), bb = *(const LAS f32x4*)(Bv + 4 * lane + 256 * j);
        const f32x4 y = v[j] * rstd * a + bb;
        o8[64 * j] = (unsigned long long)pk2(y.x, y.y) | ((unsigned long long)pk2(y.z, y.w) << 32); }
}
__device__ __forceinline__ void conv_item(int m0, const bf16* Z, const LAS float* wl  , const float* b_dw, const float* ln_g, const float* ln_b, bf16* CO, int lane) {
    const int t0 = m0 & (T - 1); const size_t bbase = (size_t)(m0 - t0);
    float acc[8][8];
    { const f32x4 b0 = *(const f32x4*)(b_dw + 8 * lane), b1 = *(const f32x4*)(b_dw + 8 * lane + 4);
#pragma unroll
      for (int tt = 0; tt < 8; ++tt) { acc[tt][0] = b0.x; acc[tt][1] = b0.y; acc[tt][2] = b0.z; acc[tt][3] = b0.w; acc[tt][4] = b1.x; acc[tt][5] = b1.y; acc[tt][6] = b1.z; acc[tt][7] = b1.w; } }
#pragma unroll
    for (int i = 0; i < 38; ++i) {
        const int tin = t0 - 30 + i;
        if (tin >= 0) {
            const v4u zr = *(const GAS v4u*)(Z + (bbase + tin) * 512 + 8 * lane);
            float zf[8]; zf[0] = bflo(zr.x); zf[1] = bfhi(zr.x); zf[2] = bflo(zr.y); zf[3] = bfhi(zr.y); zf[4] = bflo(zr.z); zf[5] = bfhi(zr.z); zf[6] = bflo(zr.w); zf[7] = bfhi(zr.w);
#pragma unroll
            for (int tt = 0; tt < 8; ++tt) { const int j = i - tt;
                if (j >= 0 && j <= 30) { const f32x4 w0 = *(const LAS f32x4*)(wl + j * 512 + 8 * lane), w1 = *(const LAS f32x4*)(wl + j * 512 + 8 * lane + 4);
                    acc[tt][0] += w0.x * zf[0]; acc[tt][1] += w0.y * zf[1]; acc[tt][2] += w0.z * zf[2]; acc[tt][3] += w0.w * zf[3];
                    acc[tt][4] += w1.x * zf[4]; acc[tt][5] += w1.y * zf[5]; acc[tt][6] += w1.z * zf[6]; acc[tt][7] += w1.w * zf[7]; } }
        }
    }
    const f32x4 g0 = *(const f32x4*)(ln_g + 8 * lane), g1 = *(const f32x4*)(ln_g + 8 * lane + 4), h0 = *(const f32x4*)(ln_b + 8 * lane), h1 = *(const f32x4*)(ln_b + 8 * lane + 4);
    const float gg[8] = {g0.x, g0.y, g0.z, g0.w, g1.x, g1.y, g1.z, g1.w}, hh[8] = {h0.x, h0.y, h0.z, h0.w, h1.x, h1.y, h1.z, h1.w};
#pragma unroll
    for (int tt = 0; tt < 8; ++tt) {
        float s = 0.f;
#pragma unroll
        for (int c = 0; c < 8; ++c) s += acc[tt][c];
        const float mean = wave_sum(s) * (1.f / CC); float q = 0.f;
#pragma unroll
        for (int c = 0; c < 8; ++c) { const float d = acc[tt][c] - mean; q += d * d; }
        const float rstd = 1.f / sqrtf(wave_sum(q) * (1.f / CC) + EPS);
        float y[8];
#pragma unroll
        for (int c = 0; c < 8; ++c) { const float u = (acc[tt][c] - mean) * rstd * gg[c] + hh[c]; y[c] = u * sigmf(u); }
        v4u o; o.x = pk2(y[0], y[1]); o.y = pk2(y[2], y[3]); o.z = pk2(y[4], y[5]); o.w = pk2(y[6], y[7]);
        *(GAS v4u*)(CO + (size_t)(m0 + tt) * 512 + 8 * lane) = o;
    }
}


#if defined(CHECKS)
__device__ __forceinline__ unsigned hash_u32(unsigned x) { x ^= x >> 16; x *= 0x7feb352du; x ^= x >> 15; x *= 0x846ca68bu; x ^= x >> 16; return x; }
__device__ __forceinline__ float bf2f(bf16 v) { return __builtin_bit_cast(float, (unsigned)v << 16); }
__device__ __forceinline__ float rbf(float v) { return __builtin_bit_cast(float, f2bf(v) << 16); }
__device__ __forceinline__ float wdot(const bf16* arow, const float* W, int K, int N, int col, int lane) {
    float s = 0.f; for (int k = lane; k < K; k += 64) s = __builtin_fmaf(bf2f(arow[k]), rbf(W[(size_t)k * N + col]), s); return wave_sum(s); }
__device__ __forceinline__ void chk_fail(gu32* ctl, bool bad) { if (bad) __hip_atomic_store(ctl + CW_CHK, 1u, RLX_AGENT); }
__device__ __forceinline__ bool far(float got, float exp, float rel, float abs_) { const float d = fabsf(got - exp); return !(d <= rel * fabsf(exp) + abs_); }
#define CHK_ON(id) ((CHECKS >> (id)) & 1)
#endif
#if defined(TWOLAUNCH)
#ifndef TWOLAUNCH_LO
#define TWOLAUNCH_LO 0
#define TWOLAUNCH_HI 0
#endif
#if defined(TWOLAUNCH_RECHECK)
#define TL_CMP 0
#else
#define TL_CMP 1
#endif
#define TL_CHECK(ph) do { if ((ph) == TWOLAUNCH_PH) { \
    GRID_BAR(); \
    const GAS unsigned* p_ = (TWOLAUNCH_WHAT == 0) ? (const GAS unsigned*)out : (const GAS unsigned*)(ws + (size_t)TWOLAUNCH_LO * MiB); \
    const size_t n_ = (TWOLAUNCH_WHAT == 0) ? (size_t)M * D : ((size_t)(TWOLAUNCH_HI - TWOLAUNCH_LO) * MiB) / 4; \
    unsigned acc_ = 0u; \
    for (size_t i_ = (size_t)blockIdx.x * 512 + F.tid; i_ < n_; i_ += (size_t)F.G * 512) acc_ += p_[i_] * (unsigned)(2654435761u + (unsigned)i_); \
    __hip_atomic_fetch_add(F.ctl + 8 + (int)args.flags, acc_, RLX_AGENT); \
    GRID_BAR(); \
    if (TL_CMP && args.flags == 1ull && F.tid == 0 && (__hip_atomic_load(F.ctl + 8, RLX_AGENT) != __hip_atomic_load(F.ctl + 9, RLX_AGENT))) __hip_atomic_store(F.ctl + CW_CHK, 1u, RLX_AGENT); \
  } } while (0)
#else
#define TL_CHECK(ph) do {} while (0)
#endif

struct Args { const float* in[17]; float* out; unsigned char* ws; int ph_lo, ph_hi; unsigned long long flags; };
constexpr int N_PHASES = 11;
__global__ void __launch_bounds__(NWAVES * 64, 2) mk_fwd(Args args) {
    extern __shared__ __attribute__((aligned(16))) unsigned char lds[];
    Frame F;
    F.lds = (LAS unsigned char*)lds;
    F.MISC = (volatile LAS unsigned*)(F.lds + MISC_OFF);
    F.tid = threadIdx.x; F.lane = F.tid & 63; F.wave = __builtin_amdgcn_readfirstlane(F.tid >> 6);
    F.G = gridDim.x; { const int bx = blockIdx.x; F.vcu = (F.G % 8 == 0) ? (bx % 8) * (F.G / 8) + bx / 8 : bx; }
    unsigned char* ws = args.ws;
    F.ctl = (gu32*)(ws + WS_CTL);
    const float* x = args.in[0]; const float* c_in = args.in[1]; const float* norm_mix_g = args.in[2]; const float* w_in = args.in[3]; const float* w_dw = args.in[4];
    const float* b_dw = args.in[5]; const float* conv_ln_g = args.in[6]; const float* conv_ln_b = args.in[7]; const float* w_attn_proj = args.in[8]; const float* w_conv_proj = args.in[9];
    const float* w_out = args.in[10]; const float* norm_ffn_g = args.in[11]; const float* w_ffn_in = args.in[12]; const float* w_ffn_out = args.in[13]; const float* w_ada = args.in[14];
    const float* b_ada = args.in[15]; const float* norm_final_g = args.in[16];
    float* out = args.out;
    bf16* Win_t = (bf16*)(ws + WS_WIN); bf16* Wap_t = (bf16*)(ws + WS_WAP); bf16* Wcp_t = (bf16*)(ws + WS_WCP); bf16* Wout_t = (bf16*)(ws + WS_WOUT);
    bf16* Wff1_t = (bf16*)(ws + WS_WFF1); bf16* Wff2_t = (bf16*)(ws + WS_WFF2);
    float* MOD = (float*)(ws + WS_MOD); float* MODP = (float*)(ws + WS_MODP);
    bf16* KIb = (bf16*)(ws + WS_KI); float* WIb = (float*)(ws + WS_WI); bf16* XN = (bf16*)(ws + WS_XN);
    bf16* Qb = (bf16*)(ws + WS_Q); bf16* Kb = (bf16*)(ws + WS_K); bf16* Vb = (bf16*)(ws + WS_V); bf16* QIb = (bf16*)(ws + WS_QI); bf16* Zb = (bf16*)(ws + WS_Z);
    bf16* SGA = (bf16*)(ws + WS_SGA); bf16* SGB = (bf16*)(ws + WS_SGB); unsigned* MASKb = (unsigned*)(ws + WS_MASK); bf16* COb = (bf16*)(ws + WS_CO);
    bf16* T1b = (bf16*)(ws + WS_V);
    bf16* MERGED = (bf16*)(ws + WS_MERGED); bf16* XN2 = (bf16*)(ws + WS_XN2); bf16* Hb = (bf16*)(ws + WS_H);

    for (int u = F.tid; u < (LDS_BYTES - LDSCTL_OFF) / 4; u += NWAVES * 64) ((LAS unsigned*)(F.lds + LDSCTL_OFF))[u] = 0u;
    __syncthreads();
    XcdBarrier bar = xcd_barrier_post((unsigned*)(F.ctl + CW_BAR), F.MISC + 8);
    const int lo = args.ph_lo, hi = args.ph_hi;
#define IN(k) (lo <= (k) && (k) < hi)
#define BOTH(k) (IN(k) && IN((k) + 1))
#define GRID_BAR() xcd_barrier(bar)
    const int gw = F.vcu * NWAVES + F.wave, NGW = F.G * NWAVES;
#if defined(SWAPTEST)
    {
        unsigned a_ = (unsigned)F.lane, b_ = 100u + (unsigned)F.lane; asm volatile("" : "+v"(a_), "+v"(b_));
        const auto r_ = __builtin_amdgcn_permlane32_swap(a_, b_, false, false);
        const unsigned e0 = (F.lane < 32) ? (unsigned)F.lane : 100u + (unsigned)(F.lane - 32), e1 = (F.lane < 32) ? (unsigned)(F.lane + 32) : 100u + (unsigned)F.lane;
#if SWAPTEST == 1
        const bool bad_ = (r_[0] != e0) || (r_[1] != e1);
#else
        const unsigned f0 = (F.lane < 32) ? 100u + (unsigned)(F.lane + 32) : (unsigned)F.lane, f1 = (F.lane < 32) ? 100u + (unsigned)F.lane : (unsigned)(F.lane - 32);
        const bool bad_ = (r_[0] != f0) || (r_[1] != f1);
#endif
        if (bad_) __hip_atomic_store(F.ctl + CW_CHK, 1u, RLX_AGENT);
    }
#endif
#if defined(TWOLAUNCH) && defined(TWOLAUNCH_RECHECK)
    if (args.flags == 1ull) {
        const GAS unsigned* p_ = (const GAS unsigned*)(ws + (size_t)TWOLAUNCH_LO * MiB); const size_t n_ = ((size_t)(TWOLAUNCH_HI - TWOLAUNCH_LO) * MiB) / 4; unsigned acc_ = 0u;
        for (size_t i_ = (size_t)blockIdx.x * 512 + F.tid; i_ < n_; i_ += (size_t)F.G * 512) acc_ += p_[i_] * (unsigned)(2654435761u + (unsigned)i_);
        __hip_atomic_fetch_add(F.ctl + 10, acc_, RLX_AGENT);
        GRID_BAR();
        if (F.tid == 0 && (__hip_atomic_load(F.ctl + 8, RLX_AGENT) != __hip_atomic_load(F.ctl + 10, RLX_AGENT))) __hip_atomic_store(F.ctl + CW_CHK, 1u, RLX_AGENT);
    }
#endif

#if defined(PREFILL)
    {
        const size_t lo_b = (size_t)PREFILL_LO * MiB, hi_b = (size_t)PREFILL_HI * MiB; const size_t n16 = (hi_b - lo_b) / 16;
        GAS v4u* p = (GAS v4u*)(ws + lo_b);
        for (size_t i = (size_t)blockIdx.x * 512 + F.tid; i < n16; i += (size_t)F.G * 512) p[i] = (v4u){0x3c003c00u, 0x3c003c00u, 0x3c003c00u, 0x3c003c00u};
        GRID_BAR();
    }
#endif
#if defined(L2TEST)
    {
        GAS unsigned* R = (GAS unsigned*)(ws + (size_t)246 * MiB);
        const int w = blockIdx.x;
        for (int i = F.tid; i < 1024; i += 512) R[w * 1024 + i] = 0xA0000000u + (unsigned)(w * 1024 + i);
        GRID_BAR();
        { unsigned bad = 0u; for (int i = F.tid; i < 256 * 1024; i += 512) bad |= (R[i] != 0xA0000000u + (unsigned)i); if (bad) __hip_atomic_store(F.ctl + CW_CHK, 1u, RLX_AGENT); }
        GRID_BAR();
        { const int w2 = (w + L2TEST) & 255; for (int i = F.tid; i < 1024; i += 512) R[w2 * 1024 + i] = 0xB0000000u + (unsigned)(w2 * 1024 + i); }
        GRID_BAR();
        { unsigned bad = 0u; for (int i = F.tid; i < 256 * 1024; i += 512) bad |= (R[i] != 0xB0000000u + (unsigned)i); if (bad) __hip_atomic_store(F.ctl + CW_CHK, 1u, RLX_AGENT); }
        GRID_BAR();
    }
#endif
    if (IN(0)) {
        for (int it = gw; it < 16 * 96; it += NGW) {
            const int kc = it / 96, cc = it % 96, n = cc * 64 + F.lane, k0 = kc * 64; float a0 = 0.f, a1 = 0.f;
#pragma unroll 8
            for (int kk = 0; kk < 64; ++kk) { const float w = w_ada[(size_t)(k0 + kk) * (NMOD * D) + n]; const float c0 = c_in[k0 + kk], c1 = c_in[D + k0 + kk];
                a0 = __builtin_fmaf(c0 * sigmf(c0), w, a0); a1 = __builtin_fmaf(c1 * sigmf(c1), w, a1); }
            MODP[(size_t)(kc * 2 + 0) * (NMOD * D) + n] = a0; MODP[(size_t)(kc * 2 + 1) * (NMOD * D) + n] = a1;
        }
        LAS float* scr = (LAS float*)(F.lds + RING_OFF + F.wave * 16384);
        constexpr int I_IN = (D / 64) * (NIN_PAD / 32), I_AP = (AW / 64) * (D / 32), I_CP = I_AP, I_OUT = (D / 64) * (D / 32), I_F1 = (D / 64) * (NFF1 / 32), I_F2 = (DFF / 64) * (D / 32);
        constexpr int NITEMS = I_IN + I_AP + I_CP + I_OUT + I_F1 + I_F2;
        for (int it = gw; it < NITEMS; it += NGW) {
            int r = it; int sc0, nv;
            if (r < I_IN) { const int nblk = NIN_PAD / 32, kb = r / nblk, nb = r % nblk; win_map(32 * nb, sc0, nv); p0_transpose_item(w_in, D, NIN, Win_t, kb, 32 * nb, sc0, nv, scr, F.lane); continue; } r -= I_IN;
            if (r < I_AP) { const int nblk = D / 32, kb = r / nblk, nb = r % nblk; p0_transpose_item(w_attn_proj, AW, D, Wap_t, kb, 32 * nb, 32 * nb, 32, scr, F.lane); continue; } r -= I_AP;
            if (r < I_CP) { const int nblk = D / 32, kb = r / nblk, nb = r % nblk; p0_transpose_item(w_conv_proj, CC, D, Wcp_t, kb, 32 * nb, 32 * nb, 32, scr, F.lane); continue; } r -= I_CP;
            if (r < I_OUT) { const int nblk = D / 32, kb = r / nblk, nb = r % nblk; p0_transpose_item(w_out, D, D, Wout_t, kb, 32 * nb, 32 * nb, 32, scr, F.lane); continue; } r -= I_OUT;
            if (r < I_F1) { const int nblk = NFF1 / 32, kb = r / nblk, nb = r % nblk; ff1_map(32 * nb, sc0, nv); p0_transpose_item(w_ffn_in, D, NFF1, Wff1_t, kb, 32 * nb, sc0, nv, scr, F.lane); continue; } r -= I_F1;
            { const int nblk = D / 32, kb = r / nblk, nb = r % nblk; p0_transpose_item(w_ffn_out, DFF, D, Wff2_t, kb, 32 * nb, 32 * nb, 32, scr, F.lane); }
        }
        TL_CHECK(0); if (BOTH(0)) GRID_BAR();
    }
    if (IN(1)) {
#if defined(CHECK_W)
        {
            const size_t lo_b = (size_t)1 * MiB, hi_b = (size_t)34 * MiB; const size_t n16 = (hi_b - lo_b) / 16; const GAS v4u* p = (const GAS v4u*)(ws + lo_b); unsigned bad = 0u;
            for (size_t i = (size_t)blockIdx.x * 512 + F.tid; i < n16; i += (size_t)F.G * 512) { const v4u w = p[i]; bad += (w.x == 0x3c003c00u) + (w.y == 0x3c003c00u) + (w.z == 0x3c003c00u) + (w.w == 0x3c003c00u); }
            if (bad) __hip_atomic_fetch_add(F.ctl + 3, bad, RLX_AGENT);
        }
#endif
#if defined(PREFILL1)
        {
            const size_t lo_b = (size_t)38 * MiB, hi_b = (size_t)70 * MiB; const size_t n16 = (hi_b - lo_b) / 16;
            GAS v4u* p = (GAS v4u*)(ws + lo_b);
            for (size_t i = (size_t)blockIdx.x * 512 + F.tid; i < n16; i += (size_t)F.G * 512) p[i] = (v4u){0x3c003c00u, 0x3c003c00u, 0x3c003c00u, 0x3c003c00u};
            GRID_BAR();
        }
#endif
        LAS float* A = (LAS float*)(F.lds + RING_OFF); LAS float* Bv = A + D;
        const int b = F.vcu >> 7;
        for (int c = F.tid; c < D; c += NWAVES * 64) { float sh = b_ada[c], sc = b_ada[D + c];
#pragma unroll
            for (int kc = 0; kc < 16; ++kc) { sh += MODP[(size_t)(kc * 2 + b) * (NMOD * D) + c]; sc += MODP[(size_t)(kc * 2 + b) * (NMOD * D) + D + c]; }
            A[c] = norm_mix_g[c] * (1.f + sc); Bv[c] = sh; }
        if (F.vcu < 24) { const int o = F.vcu * 512 + F.tid, bb = o / (NMOD * D), n = o % (NMOD * D); float s = b_ada[n];
#pragma unroll
            for (int kc = 0; kc < 16; ++kc) s += MODP[(size_t)(kc * 2 + bb) * (NMOD * D) + n];
            MOD[(size_t)bb * (NMOD * D) + n] = s; }
        LDS_WAIT(); __syncthreads();
        for (int i = 0; i < 8; ++i) { const int m = F.vcu * 64 + F.wave * 8 + i; rms_row_to_bf16(x + (size_t)m * D, XN + (size_t)m * D, A, Bv, F.lane); }
        TL_CHECK(1); if (BOTH(1)) GRID_BAR();
    }
    if (IN(2)) {
#if defined(CHECK_WIN)
        {
            unsigned bad = 0u;
            for (int i = 0; i < 256; ++i) { const unsigned h = hash_u32((unsigned)((blockIdx.x * 512 + F.tid) * 256 + i + 99)); const int dr = 3072 + (int)(h % 2048u), k = (int)((h >> 11) % 1024u);
                bad |= ((unsigned)Win_t[(size_t)dr * D + k] != f2bf(w_in[(size_t)k * NIN + (dr < 4096 ? 3144 + (dr - 3072) : 4168 + (dr - 4096))])); }
            if (bad) __hip_atomic_store(F.ctl + CW_CHK, 1u, RLX_AGENT);
        }
#endif
#if defined(PREFILL) && defined(CHECK_XN)
        {
            const int sl = (F.vcu + CHECK_XN) & 255; const GAS v4u* p = (const GAS v4u*)(ws + WS_XN) + (size_t)sl * 8192; unsigned bad = 0u;
            for (int i = F.tid; i < 8192; i += NWAVES * 64) { const v4u w = p[i]; bad |= (w.x == 0x3c003c00u) | (w.y == 0x3c003c00u) | (w.z == 0x3c003c00u) | (w.w == 0x3c003c00u); }
            if (bad) __hip_atomic_store(F.ctl + CW_CHK, 1u, RLX_AGENT);
        }
#endif
        pg8::Gemm g{XN, Win_t, M, NIN_PAD, D}; pg8::StaticOrder S; S.init(M, NIN_PAD, F.G, (int)blockIdx.x);
        pg8::EpiInProj E{Qb, Kb, Vb, QIb, Zb, SGA, SGB, KIb, WIb};
        pg8::gemm_phase<pg8::EpiInProj, pg8::StaticOrder, P2_ALIGN, P2_SP2>(F.lds + RING_OFF, g, S, E);
        TL_CHECK(2); if (BOTH(2)) GRID_BAR();
    }
    if (IN(3)) {
#if defined(CHECKS)
        if (CHK_ON(19)) for (int i = 0; i < 32; ++i) { const unsigned h = hash_u32((unsigned)(gw * 277 + i + 4242)); const int m = CHK19_ROW0 + (int)(h % (unsigned)CHK19_NROW), c2 = CHK19_COL0 + (int)((h >> 14) % (unsigned)CHK19_NCOL); const bf16* xr = XN + (size_t)m * D; bool bad = false;
            if (!CHK_ON(18)) bad |= far(bf2f(SGA[(size_t)m * 1024 + c2]), sigmf(wdot(xr, w_in, D, NIN, 3144 + c2, F.lane)), CHK19_REL, CHK19_ABS);
            if (!CHK_ON(17)) bad |= far(bf2f(SGB[(size_t)m * 1024 + c2]), sigmf(wdot(xr, w_in, D, NIN, 4168 + c2, F.lane)), CHK19_REL, CHK19_ABS);
            if (bad && F.lane == 0) __hip_atomic_fetch_add(F.ctl + 3, 1u, RLX_AGENT); }
#endif

#if defined(CHECKS)
        for (int i = 0; i < 6; ++i) { const unsigned h = hash_u32((unsigned)(gw * 131 + i)); const int m = (int)(h % (unsigned)M); const int bb = m >> 13; bool bad = false;
            if (CHK_ON(1)) { const int n = (int)((h >> 8) % (unsigned)(NMOD * D)); float sacc = 0.f; for (int k = F.lane; k < D; k += 64) { const float cv = c_in[bb * D + k]; sacc = __builtin_fmaf(cv * sigmf(cv), w_ada[(size_t)k * (NMOD * D) + n], sacc); }
                const float e = wave_sum(sacc) + b_ada[n]; bad |= far(MOD[(size_t)bb * (NMOD * D) + n], e, 2e-3f, 2e-4f); }
            if (CHK_ON(2)) { const int c = (int)((h >> 10) % (unsigned)D); float s2 = 0.f; for (int k = F.lane; k < D; k += 64) { const float v = x[(size_t)m * D + k]; s2 = __builtin_fmaf(v, v, s2); }
                const float rstd = 1.f / sqrtf(wave_sum(s2) * (1.f / D) + EPS); const float e = x[(size_t)m * D + c] * rstd * norm_mix_g[c] * (1.f + MOD[(size_t)bb * (NMOD * D) + D + c]) + MOD[(size_t)bb * (NMOD * D) + c];
                bad |= far(bf2f(XN[(size_t)m * D + c]), e, 1e-2f, 1e-2f); }
            if (CHK_ON(3)) { const int c = (int)((h >> 12) % 512u); const bf16* xr = XN + (size_t)m * D;
                bad |= far(bf2f(Qb[(size_t)m * 512 + c]), pg8::QSCALE * wdot(xr, w_in, D, NIN, c, F.lane), 2e-2f, 2e-2f);
                bad |= far(bf2f(Kb[(size_t)m * 512 + c]), wdot(xr, w_in, D, NIN, 512 + c, F.lane), 2e-2f, 2e-2f);
                bad |= far(bf2f(Vb[(size_t)m * 512 + c]), wdot(xr, w_in, D, NIN, 1024 + c, F.lane), 2e-2f, 2e-2f);
                bad |= far(bf2f(QIb[(size_t)m * 512 + c]), wdot(xr, w_in, D, NIN, 1536 + c, F.lane), 2e-2f, 2e-2f);
                bad |= far(bf2f(KIb[(size_t)m * 64 + (c & 63)]), wdot(xr, w_in, D, NIN, 2048 + (c & 63), F.lane), 2e-2f, 2e-2f);
                bad |= far(WIb[(size_t)m * 8 + (c & 7)], wdot(xr, w_in, D, NIN, 2112 + (c & 7), F.lane), 2e-2f, 2e-2f);
                { const float a = wdot(xr, w_in, D, NIN, 2120 + c, F.lane), g = wdot(xr, w_in, D, NIN, 2632 + c, F.lane); bad |= far(bf2f(Zb[(size_t)m * 512 + c]), a * sigmf(g), 2e-2f, 2e-2f); }
                { const int c2 = (int)((h >> 5) % 1024u); bad |= far(bf2f(SGA[(size_t)m * 1024 + c2]), sigmf(wdot(xr, w_in, D, NIN, 3144 + c2, F.lane)), 2e-2f, 1e-2f);
                  bad |= far(bf2f(SGB[(size_t)m * 1024 + c2]), sigmf(wdot(xr, w_in, D, NIN, 4168 + c2, F.lane)), 2e-2f, 1e-2f); } }
            if (CHK_ON(14) && (int)args.flags == CHECK14_LAUNCH) { const bf16* xr2 = XN + (size_t)m * D;
                for (int q = 0; q < 8; ++q) { const unsigned h2 = hash_u32(h + 977u * (unsigned)q + 13u); const int m2 = CHK14_ROW0 + (int)(h2 % 2048u), c2 = (int)((h2 >> 11) % 1024u);
                    if (far(bf2f(CHK14_BUF[(size_t)m2 * 1024 + c2]), sigmf(wdot(XN + (size_t)m2 * D, w_in, D, NIN, CHK14_COL + c2, F.lane)), 1e-2f, 4e-3f) && F.lane == 0) __hip_atomic_fetch_add(F.ctl + 3, 1u, RLX_AGENT); } (void)xr2; }
            chk_fail(F.ctl, bad); }
#endif
#if defined(PREFILL3)
        {
            const size_t lo_b = (size_t)38 * MiB, hi_b = (size_t)70 * MiB; const size_t n16 = (hi_b - lo_b) / 16;
            GAS v4u* p = (GAS v4u*)(ws + lo_b);
            for (size_t i = (size_t)blockIdx.x * 512 + F.tid; i < n16; i += (size_t)F.G * 512) p[i] = (v4u){0x3c003c00u, 0x3c003c00u, 0x3c003c00u, 0x3c003c00u};
        }
#endif
#if !defined(SKIP_IDX)
#if defined(IDX_DRY)
        { const int b = F.vcu >> 7, s = F.vcu & 127; idx_body::idx_unit(b, s, QIb, KIb, WIb, MASKb, (char*)lds + RING_OFF, (unsigned*)(F.ctl + CW_CHK), true); idx_body::idx_unit(b, 255 - s, QIb, KIb, WIb, MASKb, (char*)lds + RING_OFF, (unsigned*)(F.ctl + CW_CHK), true); }
#endif
        for (int rep_ = 0; rep_ < IDX_REPS; ++rep_)
        { const int b = F.vcu >> 7, s = F.vcu & 127;
          idx_body::idx_unit(b, s, QIb, KIb, WIb, MASKb, (char*)lds + RING_OFF, (unsigned*)(F.ctl + CW_CHK));
          idx_body::idx_unit(b, 255 - s, QIb, KIb, WIb, MASKb, (char*)lds + RING_OFF, (unsigned*)(F.ctl + CW_CHK)); }
#endif
        { LAS float* wl = (LAS float*)(F.lds + RING_OFF);
          for (int i = F.tid; i < CWID * CC / 4; i += NWAVES * 64) ((LAS f32x4*)wl)[i] = ((const f32x4*)w_dw)[i];
          LDS_WAIT(); __syncthreads();
#if defined(SKIP_CONV)
          for (int tt = 0; tt < 8; ++tt) *(GAS v4u*)(COb + (size_t)(8 * gw + tt) * 512 + 8 * F.lane) = (v4u){0u, 0u, 0u, 0u};
#else
          conv_item(8 * gw, Zb, wl, b_dw, conv_ln_g, conv_ln_b, COb, F.lane);
#endif
          __syncthreads(); }
        TL_CHECK(3); if (BOTH(3)) GRID_BAR();
    }
    if (IN(4)) {
#if defined(CHECKS)
        if (CHK_ON(16)) for (int i = 0; i < 8; ++i) { const unsigned h = hash_u32((unsigned)(gw * 277 + i + 4242)); const int m = (int)(h % (unsigned)M), c2 = (int)((h >> 14) % 1024u); const bf16* xr = XN + (size_t)m * D; bool bad = false;
            if (!CHK_ON(18)) bad |= far(bf2f(SGA[(size_t)m * 1024 + c2]), sigmf(wdot(xr, w_in, D, NIN, 3144 + c2, F.lane)), 2e-2f, 1e-2f);
            if (!CHK_ON(17)) bad |= far(bf2f(SGB[(size_t)m * 1024 + c2]), sigmf(wdot(xr, w_in, D, NIN, 4168 + c2, F.lane)), 2e-2f, 1e-2f);
            chk_fail(F.ctl, bad); }
#endif
#if defined(LDS_FILL)
        { for (int i = F.tid; i < RING_BYTES / 4; i += NWAVES * 64) ((LAS unsigned*)(F.lds + RING_OFF))[i] = (unsigned)LDS_FILL; LDS_WAIT(); __syncthreads(); }
#endif
#if defined(SKIP_ATT)
        for (int i = 0; i < 64; ++i) { const int m = F.vcu * 64 + i; ((GAS unsigned short*)Qb)[(size_t)m * 512 + F.tid] = 0; }
#else
#if defined(ATT_TWICE)
        { GAS v4u* Qv = (GAS v4u*)Qb; GAS v4u* S1 = (GAS v4u*)(ws + (size_t)38 * MiB); const size_t n16 = (size_t)M * 512 * 2 / 16;
          for (size_t i = (size_t)blockIdx.x * 512 + F.tid; i < n16; i += (size_t)F.G * 512) S1[i] = Qv[i];
          GRID_BAR(); }
#endif
#if defined(ATT_DRY)
        { const attn_body::AttnTensors ATd{(const attn_body::bf16*)Qb, (const attn_body::bf16*)Kb, (const attn_body::bf16*)Vb, (attn_body::bf16*)out, (const unsigned long long*)MASKb};
          const attn_body::StaticOrder Sd((int)F.G, (int)blockIdx.x);
          attn_body::attn_phase<attn_body::StaticOrder, ATT_THRL>((char*)lds + RING_OFF, ATd, Sd); }
#endif
        const attn_body::AttnTensors AT{(const attn_body::bf16*)Qb, (const attn_body::bf16*)Kb, (const attn_body::bf16*)Vb, (attn_body::bf16*)Qb, (const unsigned long long*)MASKb};
        const attn_body::StaticOrder S((int)F.G, (int)blockIdx.x);
        attn_body::attn_phase<attn_body::StaticOrder, ATT_THRL>((char*)lds + RING_OFF, AT, S);
#endif
#if defined(ATT_TWICE)
        {
            GAS v4u* Qv = (GAS v4u*)Qb; GAS v4u* S1 = (GAS v4u*)(ws + (size_t)38 * MiB); GAS v4u* S2 = (GAS v4u*)(ws + (size_t)54 * MiB); const size_t n16 = (size_t)M * 512 * 2 / 16;
            GRID_BAR();
            for (size_t i = (size_t)blockIdx.x * 512 + F.tid; i < n16; i += (size_t)F.G * 512) { S2[i] = Qv[i]; Qv[i] = S1[i]; }
            GRID_BAR();
            { const attn_body::AttnTensors AT2{(const attn_body::bf16*)Qb, (const attn_body::bf16*)Kb, (const attn_body::bf16*)Vb, (attn_body::bf16*)Qb, (const unsigned long long*)MASKb};
              const attn_body::StaticOrder S2o((int)F.G, (int)blockIdx.x);
              attn_body::attn_phase<attn_body::StaticOrder, ATT_THRL>((char*)lds + RING_OFF, AT2, S2o); }
            GRID_BAR();
            { unsigned bad = 0u; for (size_t i = (size_t)blockIdx.x * 512 + F.tid; i < n16; i += (size_t)F.G * 512) { const v4u a = S2[i], b = Qv[i]; bad |= (a.x != b.x) | (a.y != b.y) | (a.z != b.z) | (a.w != b.w); }
              if (bad) __hip_atomic_store(F.ctl + CW_CHK, 1u, RLX_AGENT); }
        }
#endif
        TL_CHECK(4); if (BOTH(4)) GRID_BAR();
    }
#if defined(DUMP_P4)
    {
        for (int i = 0; i < 64; ++i) { const int m = F.vcu * 64 + i; const int c = F.tid * 2;
            const bf16* src = (c < 512) ? (Qb + (size_t)m * 512 + c) : (COb + (size_t)m * 512 + (c - 512));
            const unsigned w = *(const unsigned*)src; out[(size_t)m * D + c] = bflo(w); out[(size_t)m * D + c + 1] = bfhi(w); }
        return;
    }
#endif
    if (IN(5)) {

#if defined(CHECKS)
        if (CHK_ON(11)) { const unsigned h = hash_u32((unsigned)(gw * 7 + 12345)); const int bb = (int)(h & 1u); int t = (int)((h >> 1) % (unsigned)T); if ((gw & 7) == 0) t = (int)((h >> 1) % 600u);
            const bf16* qi = QIb + (size_t)(bb * T + t) * 512; const float* wi = WIb + (size_t)(bb * T + t) * 8;
            const unsigned long long* mrow_ = (const unsigned long long*)MASKb + ((size_t)(bb * (T / 32) + (t >> 5)) * (T / 64)) * 32 + (t & 31);
            int nsel = 0; float mn = INFINITY, mx = -INFINITY;
            for (int s0 = 0; s0 <= t; s0 += 64) { const int sidx = s0 + F.lane; const bool act = sidx <= t; float sc = 0.f;
                if (act) { const bf16* kr = KIb + (size_t)(bb * T + sidx) * 64;
                    for (int j = 0; j < 8; ++j) { float d = 0.f; for (int k = 0; k < 64; ++k) d = __builtin_fmaf(bf2f(qi[j * 64 + k]), bf2f(kr[k]), d); sc = __builtin_fmaf(wi[j], fmaxf(d, 0.f), sc); } }
                const unsigned long long mw = mrow_[(size_t)(s0 >> 6) * 32]; const bool selb = (mw >> F.lane) & 1ull;
                if (act) { if (selb) { ++nsel; mn = fminf(mn, sc); } else mx = fmaxf(mx, sc); } else if (selb) nsel += 100000; }
            for (int o = 1; o < 64; o <<= 1) { nsel += __shfl_xor(nsel, o); mn = fminf(mn, __shfl_xor(mn, o)); mx = fmaxf(mx, __shfl_xor(mx, o)); }
            const int want = (t + 1 < 256) ? t + 1 : 256;
            bool bad = (nsel != want); if (CHK_ON(13) && t + 1 > 256) bad |= !(mn >= mx - (1e-2f * fabsf(mx) + 1e-2f));
            for (int tt = (t >> 6) + 1 + F.lane; tt < T / 64; tt += 64) bad |= (mrow_[(size_t)tt * 32] != 0ull);
            chk_fail(F.ctl, __any(bad)); }
        if (CHK_ON(12)) { const unsigned h = hash_u32((unsigned)(gw * 13 + 777)); const int bb = (int)(h & 1u), hd = (int)((h >> 1) & 7u); int t = (int)((h >> 4) % (unsigned)T); if ((gw & 7) == 0) t = (int)((h >> 4) % 600u);
            const size_t row = (size_t)(bb * T + t);
            const float qd = rbf(pg8::QSCALE * ({ float sacc = 0.f; for (int k = 0; k < D; ++k) sacc = __builtin_fmaf(bf2f(XN[row * D + k]), rbf(w_in[(size_t)k * NIN + hd * 64 + F.lane]), sacc); sacc; }));
            const unsigned long long* mrow_ = (const unsigned long long*)MASKb + ((size_t)(bb * (T / 32) + (t >> 5)) * (T / 64)) * 32 + (t & 31);
#if defined(ATT_NOALIBI)
            const float slope2 = 0.f;
#else
            const float slope2 = exp2f(-(float)(hd + 1)) * 1.4426950408889634f;
#endif
            float mrun = -INFINITY, l = 0.f, o = 0.f;
            for (int tt = 0; tt <= (t >> 6); ++tt) {
#if defined(ATT_DENSE)
                const int dd_ = t - 64 * tt; const unsigned long long mw = (dd_ >= 63) ? ~0ull : ((2ull << dd_) - 1ull);
#else
                const unsigned long long mw = mrow_[(size_t)tt * 32];
#endif
                for (int kk = 0; kk < 64; ++kk) if ((mw >> kk) & 1ull) { const int sidx = tt * 64 + kk; const size_t kr = (size_t)(bb * T + sidx);
                    const float lg = wave_sum(qd * bf2f(Kb[kr * 512 + hd * 64 + F.lane])) + slope2 * (float)(sidx - t);
                    const float mnew = fmaxf(mrun, lg); const float f = exp2f(mrun - mnew), p = exp2f(lg - mnew); l = l * f + p; o = o * f + p * bf2f(Vb[kr * 512 + hd * 64 + F.lane]); mrun = mnew; } }
            const float e = o / l; chk_fail(F.ctl, __any(far(bf2f(Qb[row * 512 + hd * 64 + F.lane]), e, 3e-2f, 2e-2f))); }
        if (CHK_ON(15)) for (int i = 0; i < 8; ++i) { const unsigned h = hash_u32((unsigned)(gw * 271 + i + 4242)); const int m = (int)(h % (unsigned)M), c2 = (int)((h >> 14) % 1024u); const bf16* xr = XN + (size_t)m * D; bool bad = false;
            if (!CHK_ON(18)) bad |= far(bf2f(SGA[(size_t)m * 1024 + c2]), sigmf(wdot(xr, w_in, D, NIN, 3144 + c2, F.lane)), 2e-2f, 1e-2f);
            if (!CHK_ON(17)) bad |= far(bf2f(SGB[(size_t)m * 1024 + c2]), sigmf(wdot(xr, w_in, D, NIN, 4168 + c2, F.lane)), 2e-2f, 1e-2f);
            chk_fail(F.ctl, bad); }
        if (CHECKS & 0xb800) GRID_BAR();
#endif
        { pg8::Gemm g{Qb, Wap_t, M, D, AW}; pg8::StaticOrder S; S.init(M, D, F.G, (int)blockIdx.x);
          pg8::EpiGate<0> E{SGA, T1b, nullptr};
          pg8::gemm_phase<pg8::EpiGate<0>, pg8::StaticOrder, true, true>(F.lds + RING_OFF, g, S, E); }
        VM_WAIT(); __syncthreads();
        { pg8::Gemm g{COb, Wcp_t, M, D, CC}; pg8::StaticOrder S; S.init(M, D, F.G, (int)blockIdx.x);
          pg8::EpiGate<1> E{SGB, MERGED, T1b};
          pg8::gemm_phase<pg8::EpiGate<1>, pg8::StaticOrder, true, true>(F.lds + RING_OFF, g, S, E); }
        TL_CHECK(5); if (BOTH(5)) GRID_BAR();
    }
    if (IN(6)) {

#if defined(CHECKS)
        for (int i = 0; i < 4; ++i) { const unsigned h = hash_u32((unsigned)(gw * 977 + i + 77)); const int m = (int)(h % (unsigned)M); bool bad = false;
            if (CHK_ON(4)) { const int t0 = m & (T - 1); float v[8]; const f32x4 b0 = *(const f32x4*)(b_dw + 8 * F.lane), b1 = *(const f32x4*)(b_dw + 8 * F.lane + 4);
                v[0] = b0.x; v[1] = b0.y; v[2] = b0.z; v[3] = b0.w; v[4] = b1.x; v[5] = b1.y; v[6] = b1.z; v[7] = b1.w;
                for (int j = 0; j < CWID; ++j) { const int tin = t0 - 30 + j; if (tin >= 0) { for (int c = 0; c < 8; ++c) v[c] = __builtin_fmaf(w_dw[j * CC + 8 * F.lane + c], bf2f(Zb[(size_t)(m - t0 + tin) * 512 + 8 * F.lane + c]), v[c]); } }
                float sacc = 0.f; for (int c = 0; c < 8; ++c) sacc += v[c]; const float mean = wave_sum(sacc) * (1.f / CC); float q = 0.f; for (int c = 0; c < 8; ++c) q += (v[c] - mean) * (v[c] - mean);
                const float rstd = 1.f / sqrtf(wave_sum(q) * (1.f / CC) + EPS);
                for (int c = 0; c < 8; ++c) { const float u = (v[c] - mean) * rstd * conv_ln_g[8 * F.lane + c] + conv_ln_b[8 * F.lane + c]; bad |= far(bf2f(COb[(size_t)m * 512 + 8 * F.lane + c]), u * sigmf(u), 3e-2f, 3e-2f); } }
            if (CHK_ON(5)) { const int c = (int)((h >> 9) % 1024u);
                const float e = bf2f(SGA[(size_t)m * 1024 + c]) * wdot(Qb + (size_t)m * 512, w_attn_proj, AW, D, c, F.lane) + bf2f(SGB[(size_t)m * 1024 + c]) * wdot(COb + (size_t)m * 512, w_conv_proj, CC, D, c, F.lane);
                bad |= far(bf2f(MERGED[(size_t)m * 1024 + c]), e, 3e-2f, 3e-2f); }
            chk_fail(F.ctl, bad); }
#endif
        pg8::Gemm g{MERGED, Wout_t, M, D, D}; pg8::StaticOrder S; S.init(M, D, F.G, (int)blockIdx.x);
        pg8::EpiResid E{x, out, MOD + 2 * D, NMOD * D};
        pg8::gemm_phase<pg8::EpiResid, pg8::StaticOrder, true, true>(F.lds + RING_OFF, g, S, E);
        TL_CHECK(6); if (BOTH(6)) GRID_BAR();
    }
    if (IN(7)) {

#if defined(CHECKS)
        if (CHK_ON(6)) for (int i = 0; i < 4; ++i) { const unsigned h = hash_u32((unsigned)(gw * 613 + i + 991)); const int m = (int)(h % (unsigned)M), c = (int)((h >> 14) % 1024u), bb = m >> 13;
            const float e = x[(size_t)m * D + c] + MOD[(size_t)bb * (NMOD * D) + 2 * D + c] * wdot(MERGED + (size_t)m * 1024, w_out, D, D, c, F.lane);
            chk_fail(F.ctl, far(out[(size_t)m * D + c], e, 1e-2f, 1e-2f)); }
#endif
        LAS float* A = (LAS float*)(F.lds + RING_OFF); LAS float* Bv = A + D;
        const int b = F.vcu >> 7;
        for (int c = F.tid; c < D; c += NWAVES * 64) { A[c] = norm_ffn_g[c] * (1.f + MOD[(size_t)b * (NMOD * D) + 4 * D + c]); Bv[c] = MOD[(size_t)b * (NMOD * D) + 3 * D + c]; }
        LDS_WAIT(); __syncthreads();
        for (int i = 0; i < 8; ++i) { const int m = F.vcu * 64 + F.wave * 8 + i; rms_row_to_bf16(out + (size_t)m * D, XN2 + (size_t)m * D, A, Bv, F.lane); }
        TL_CHECK(7); if (BOTH(7)) GRID_BAR();
    }
    if (IN(8)) {

#if defined(CHECKS)
        if (CHK_ON(8)) for (int i = 0; i < 4; ++i) { const unsigned h = hash_u32((unsigned)(gw * 419 + i + 5)); const int m = (int)(h % (unsigned)M), c = (int)((h >> 14) % 1024u), bb = m >> 13;
            float s2 = 0.f; for (int k = F.lane; k < D; k += 64) { const float v = out[(size_t)m * D + k]; s2 = __builtin_fmaf(v, v, s2); }
            const float rstd = 1.f / sqrtf(wave_sum(s2) * (1.f / D) + EPS); const float e = out[(size_t)m * D + c] * rstd * norm_ffn_g[c] * (1.f + MOD[(size_t)bb * (NMOD * D) + 4 * D + c]) + MOD[(size_t)bb * (NMOD * D) + 3 * D + c];
            chk_fail(F.ctl, far(bf2f(XN2[(size_t)m * D + c]), e, 1e-2f, 1e-2f)); }
#endif
        pg8::Gemm g{XN2, Wff1_t, M, NFF1, D}; pg8::StaticOrder S; S.init(M, NFF1, F.G, (int)blockIdx.x);
        pg8::EpiSwiGLU E{Hb, DFF};
        pg8::gemm_phase<pg8::EpiSwiGLU, pg8::StaticOrder, true, true>(F.lds + RING_OFF, g, S, E);
        TL_CHECK(8); if (BOTH(8)) GRID_BAR();
    }
    if (IN(9)) {

#if defined(CHECKS)
        if (CHK_ON(7)) for (int i = 0; i < 4; ++i) { const unsigned h = hash_u32((unsigned)(gw * 211 + i + 3)); const int m = (int)(h % (unsigned)M), j = (int)((h >> 13) % (unsigned)DFF);
            const float a = wdot(XN2 + (size_t)m * D, w_ffn_in, D, NFF1, j, F.lane), bq = wdot(XN2 + (size_t)m * D, w_ffn_in, D, NFF1, DFF + j, F.lane);
            chk_fail(F.ctl, far(bf2f(Hb[(size_t)m * DFF + j]), a * sigmf(a) * bq, 3e-2f, 3e-2f)); }
#endif
        pg8::Gemm g{Hb, Wff2_t, M, D, DFF}; pg8::StaticOrder S; S.init(M, D, F.G, (int)blockIdx.x);
        pg8::EpiResid E{out, out, MOD + 5 * D, NMOD * D};
#if defined(P9_VARIANT)
        pg8::gemm_phase<pg8::EpiResid, pg8::StaticOrder, false, false>(F.lds + RING_OFF, g, S, E);
#else
        pg8::gemm_phase<pg8::EpiResid, pg8::StaticOrder, true, true>(F.lds + RING_OFF, g, S, E);
#endif
        TL_CHECK(9); if (BOTH(9)) GRID_BAR();
    }
    if (IN(10)) {

#if defined(CHECKS)
        if (CHK_ON(10)) for (int i = 0; i < 64; ++i) { const unsigned h = hash_u32((unsigned)((gw * 64 + F.lane) * 64 + i + 17)); const int n = (int)(h % 1024u), k = (int)((h >> 10) % (unsigned)DFF);
            const bool bad = (unsigned)Wff2_t[(size_t)n * DFF + k] != f2bf(w_ffn_out[(size_t)k * D + n]); chk_fail(F.ctl, __any(bad)); }
        if (CHK_ON(9)) for (int i = 0; i < 4; ++i) { const unsigned h = hash_u32((unsigned)(gw * 101 + i + 9)); const int m = (int)(h % (unsigned)M), c = (int)((h >> 14) % 1024u), bb = m >> 13;
            const float e = x[(size_t)m * D + c] + MOD[(size_t)bb * (NMOD * D) + 2 * D + c] * wdot(MERGED + (size_t)m * 1024, w_out, D, D, c, F.lane) + MOD[(size_t)bb * (NMOD * D) + 5 * D + c] * wdot(Hb + (size_t)m * DFF, w_ffn_out, DFF, D, c, F.lane);
            chk_fail(F.ctl, far(out[(size_t)m * D + c], e, 2e-2f, 2e-2f)); }
        GRID_BAR();
#endif
        const bool poison = (__hip_atomic_load(F.ctl + CW_TMO, RLX_AGENT) != 0u) || (__hip_atomic_load((gu32*)((unsigned*)(F.ctl + CW_BAR) + XB_TMO), RLX_AGENT) != 0u) || (__hip_atomic_load(F.ctl + CW_CHK, RLX_AGENT) != 0u) || (__hip_atomic_load(F.ctl + 3, RLX_AGENT) >= (unsigned)CNT_THRESH);
        for (int i = 0; i < 8; ++i) { const int m = F.vcu * 64 + F.wave * 8 + i;
            GAS f32x4* xr = (GAS f32x4*)(out + (size_t)m * D) + F.lane; f32x4 v[4]; float s2 = 0.f;
#pragma unroll
            for (int j = 0; j < 4; ++j) { v[j] = xr[64 * j]; s2 += (v[j].x * v[j].x + v[j].y * v[j].y) + (v[j].z * v[j].z + v[j].w * v[j].w); }
            const float rstd = 1.f / sqrtf(wave_sum(s2) * (1.f / D) + EPS);
#pragma unroll
            for (int j = 0; j < 4; ++j) { const f32x4 gv = *(const f32x4*)(norm_final_g + 4 * F.lane + 256 * j); f32x4 y = v[j] * rstd * gv;
                if (poison) { const float q = __builtin_nanf(""); y = (f32x4){q, q, q, q}; } xr[64 * j] = y; } }
    }
#undef IN
#undef BOTH
#undef GRID_BAR
}

extern "C" void kernel_launch(void* const* d_in, const int* in_sizes, int n_in, void* d_out, int out_size, void* d_ws, size_t ws_size, hipStream_t stream) {
    static int grid = 0;
    if (grid == 0) {
        if (n_in != 17 || in_sizes[0] != M * D || out_size != M * D || ws_size < WS_END) { fprintf(stderr, "kernel_launch: unexpected problem shape (n_in %d, in0 %d, out %d, ws %zu); nothing launched\n", n_in, n_in > 0 ? in_sizes[0] : -1, out_size, ws_size); grid = -1; return; }
        int dev = 0, cus = 0, per_cu = 0;
        if (hipGetDevice(&dev) != hipSuccess || hipDeviceGetAttribute(&cus, hipDeviceAttributeMultiprocessorCount, dev) != hipSuccess) { fprintf(stderr, "kernel_launch: device query failed\n"); grid = -1; return; }
        if (hipFuncSetAttribute((const void*)mk_fwd, hipFuncAttributeMaxDynamicSharedMemorySize, LDS_BYTES) != hipSuccess) { fprintf(stderr, "kernel_launch: hipFuncSetAttribute failed\n"); grid = -1; return; }
        if (hipOccupancyMaxActiveBlocksPerMultiprocessor(&per_cu, (const void*)mk_fwd, NWAVES * 64, LDS_BYTES) != hipSuccess || per_cu < 1)
            fprintf(stderr, "kernel_launch: note: occupancy query reports %d workgroups per CU\n", per_cu);
        (void)hipGetLastError();
        grid = cus;
        if (grid != 256) fprintf(stderr, "kernel_launch: %d CUs; this kernel is built for 256\n", grid);
    }
    if (grid < 0) return;
    if (hipMemsetAsync((char*)d_ws + WS_CTL, 0, CTL_ZERO_BYTES, stream) != hipSuccess) { fprintf(stderr, "kernel_launch: hipMemsetAsync failed\n"); return; }
    Args a{};
    for (int i = 0; i < 17; ++i) a.in[i] = (const float*)d_in[i];
    a.out = (float*)d_out; a.ws = (unsigned char*)d_ws; a.ph_lo = 0; a.ph_hi = N_PHASES;
#if defined(ALIAS_CHECK)
    { const uintptr_t w0 = (uintptr_t)d_ws, w1 = w0 + (uintptr_t)WS_END; unsigned long long f = 0ull;
      for (int i = 0; i < 17; ++i) { const uintptr_t p0 = (uintptr_t)d_in[i], p1 = p0 + (uintptr_t)in_sizes[i] * 4; if (p0 < w1 && p1 > w0) f |= 1ull << i; }
      { const uintptr_t p0 = (uintptr_t)d_out, p1 = p0 + (uintptr_t)out_size * 4; if (p0 < w1 && p1 > w0) f |= 1ull << 20; }
      a.flags = f; }
#endif
#if defined(TWOLAUNCH)
#if defined(TWOLAUNCH_WARM)
    a.flags = 2ull; a.ph_lo = 0; a.ph_hi = TWOLAUNCH_PH + 1;
    hipLaunchKernelGGL(mk_fwd, dim3(grid), dim3(NWAVES * 64), LDS_BYTES, stream, a);
    (void)hipMemsetAsync((char*)d_ws + WS_CTL, 0, CTL_ZERO_BYTES, stream);
#endif
    a.flags = 0ull; a.ph_lo = 0; a.ph_hi = TWOLAUNCH_PH + 1;
    hipLaunchKernelGGL(mk_fwd, dim3(grid), dim3(NWAVES * 64), LDS_BYTES, stream, a);
    (void)hipMemsetAsync((char*)d_ws + WS_CTL + 64, 0, CTL_ZERO_BYTES - 64, stream);
    a.flags = 1ull; a.ph_lo = 0; a.ph_hi = N_PHASES;
#endif
    hipLaunchKernelGGL(mk_fwd, dim3(grid), dim3(NWAVES * 64), LDS_BYTES, stream, a);
    const hipError_t le = hipPeekAtLastError();
    if (le != hipSuccess) fprintf(stderr, "kernel_launch: launch failed: %s\n", hipGetErrorName(le));
}
```
